# Optimizing an MI355X kernel written in HIP

```python
import math
import jax, jax.numpy as jnp
from jax import lax
import numpy as np

D_MODEL = 1024
BATCH = 8
SEQ = 4096
DEPTH = 1

CHUNK = 64
N_META = 16

N_HEADS = 8
HEAD_DIM = 64
ATTN_WIDTH = N_HEADS * HEAD_DIM
Q_BLOCK = 128

POOL_WINDOWS = (2, 4, 8, 16)
POOL_GROUPS = len(POOL_WINDOWS)
POOL_WIDTH = D_MODEL // 2
POOL_GROUP_DIM = POOL_WIDTH // POOL_GROUPS

N_BRANCHES = 2

Q_OFF = 0
K_OFF = Q_OFF + ATTN_WIDTH
V_OFF = K_OFF + ATTN_WIDTH
F_OFF = V_OFF + ATTN_WIDTH
P_OFF = F_OFF + N_HEADS
G_OFF = P_OFF + POOL_WIDTH
IN_WIDTH = G_OFF + N_BRANCHES * D_MODEL

N_EXPERT_GROUPS = 4
EXPERTS_PER_GROUP = 8
EXPERT_HIDDEN = 256
TOP_K_EXPERTS = 2

RMS_EPS = 1e-6

kernel_name = "hybrid_fox_pool_hiermoe_block"


def rmsnorm(x, g):
    xf = x.astype(jnp.float32)
    y = xf * lax.rsqrt(jnp.mean(xf * xf, axis=-1, keepdims=True) + RMS_EPS)
    return (y * g.astype(jnp.float32)).astype(x.dtype)


def forgetting_attention(q, k, v, fcum):
    L = q.shape[2]
    n_blocks = -(-L // Q_BLOCK)
    pad = n_blocks * Q_BLOCK - L
    q = jnp.pad(q, ((0, 0), (0, 0), (0, pad), (0, 0)))
    k = jnp.pad(k, ((0, 0), (0, 0), (0, pad), (0, 0)))
    v = jnp.pad(v, ((0, 0), (0, 0), (0, pad), (0, 0)))
    fcum = jnp.pad(fcum, ((0, 0), (0, 0), (0, pad)))
    scale = 1.0 / math.sqrt(HEAD_DIM)
    outs = []
    for i in range(n_blocks):
        lo, hi = i * Q_BLOCK, (i + 1) * Q_BLOCK
        qb, kb, vb = q[:, :, lo:hi], k[:, :, :hi], v[:, :, :hi]
        s = jnp.einsum('bhqd,bhkd->bhqk', qb, kb).astype(jnp.float32) * scale
        s = s + (fcum[:, :, lo:hi, None] - fcum[:, :, None, :hi])
        mask = jnp.arange(hi)[None, :] <= (lo + jnp.arange(Q_BLOCK))[:, None]
        s = jnp.where(mask[None, None], s, -jnp.inf)
        p = jax.nn.softmax(s, axis=-1).astype(vb.dtype)
        outs.append(jnp.einsum('bhqk,bhkd->bhqd', p, vb))
    return jnp.concatenate(outs, axis=2)[:, :, :L]


def multiscale_pool(u, w_pool, pool_scale):
    B, L, C = u.shape
    ug = u.reshape(B, L, POOL_GROUPS, POOL_GROUP_DIM)
    cs = jnp.cumsum(ug.astype(jnp.float32), axis=1)
    cs = jnp.concatenate([jnp.zeros_like(cs[:, :1]), cs], axis=1)
    hi = jnp.arange(1, L + 1)
    windows = jnp.array(POOL_WINDOWS, dtype=jnp.int32)
    lo = jnp.maximum(hi[:, None] - windows[None, :], 0)
    grp = jnp.arange(POOL_GROUPS)[None, :]
    count = (hi[:, None] - lo).astype(jnp.float32)[None, :, :, None]
    mean = (cs[:, 1:] - cs[:, lo, grp]) / count
    mixed = (mean - ug.astype(jnp.float32)).astype(u.dtype)
    y = jnp.einsum('blgc,gcd->blgd', mixed, w_pool).reshape(B, L, C)
    return y * pool_scale


def hierarchical_moe(x2, w_group, b_group, w_router, b_router, w1, w3, w2):
    T = x2.shape[0]
    g_logits = (x2 @ w_group).astype(jnp.float32) + b_group.astype(jnp.float32)
    g_prob = jax.nn.softmax(g_logits, axis=-1)
    g_top, g_idx = lax.top_k(g_prob, 1)
    e_logits = ((x2 @ w_router).astype(jnp.float32) + b_router.astype(jnp.float32)
                ).reshape(T, N_EXPERT_GROUPS, EXPERTS_PER_GROUP)
    e_sel = jnp.take_along_axis(e_logits, g_idx[:, :, None], axis=1)[:, 0]
    e_prob = jax.nn.softmax(e_sel, axis=-1)
    e_top, e_idx = lax.top_k(e_prob, TOP_K_EXPERTS)
    e_w = e_top / jnp.sum(e_top, axis=-1, keepdims=True) * g_top
    w_within = jnp.sum(jax.nn.one_hot(e_idx, EXPERTS_PER_GROUP, dtype=jnp.float32)
                       * e_w[..., None], axis=1)
    combine = (jax.nn.one_hot(g_idx[:, 0], N_EXPERT_GROUPS, dtype=jnp.float32)[:, :, None]
               * w_within[:, None, :]).astype(x2.dtype)
    y = jnp.zeros_like(x2)
    for g in range(N_EXPERT_GROUPS):
        h1 = jnp.einsum('td,edf->tef', x2, w1[g])
        h3 = jnp.einsum('td,edf->tef', x2, w3[g])
        hh = jax.nn.silu(h1) * h3 * combine[:, g, :, None]
        y = y + jnp.einsum('tef,efd->td', hh, w2[g])
    return y


def setup_inputs(seed: int = 0) -> dict:
    key = jax.random.key(seed)
    ks = jax.random.split(key, 20)
    f32 = jnp.float32
    D, G, E, F = D_MODEL, N_EXPERT_GROUPS, EXPERTS_PER_GROUP, EXPERT_HIDDEN
    nrm = lambda k, shape, fan_in: jax.random.normal(k, shape, f32) * (fan_in ** -0.5)
    return {
        "x": jax.random.normal(ks[0], (BATCH, SEQ, D), f32),
        "meta_tokens": jax.random.normal(ks[1], (N_META, D), f32),
        "norm_mix_g": 1.0 + 0.05 * jax.random.normal(ks[2], (DEPTH, D), f32),
        "w_in": nrm(ks[3], (DEPTH, D, IN_WIDTH), D),
        "b_forget": jax.random.uniform(ks[4], (DEPTH, N_HEADS), f32, 3.0, 6.0),
        "q_norm_g": 1.0 + 0.05 * jax.random.normal(ks[5], (DEPTH, HEAD_DIM), f32),
        "k_norm_g": 1.0 + 0.05 * jax.random.normal(ks[6], (DEPTH, HEAD_DIM), f32),
        "w_up_attn": nrm(ks[7], (DEPTH, ATTN_WIDTH, D), ATTN_WIDTH),
        "w_pool": nrm(ks[8], (DEPTH, POOL_GROUPS, POOL_GROUP_DIM, POOL_GROUP_DIM), POOL_GROUP_DIM),
        "pool_scale": 1.0 + 0.1 * jax.random.normal(ks[9], (DEPTH, POOL_WIDTH), f32),
        "w_up_pool": nrm(ks[10], (DEPTH, POOL_WIDTH, D), POOL_WIDTH),
        "w_out": nrm(ks[11], (DEPTH, D, D), D),
        "norm_ffn_g": 1.0 + 0.05 * jax.random.normal(ks[12], (DEPTH, D), f32),
        "w_group": nrm(ks[13], (DEPTH, D, G), D),
        "b_group": 0.01 * jax.random.normal(ks[14], (DEPTH, G), f32),
        "w_router": nrm(ks[15], (DEPTH, D, G * E), D),
        "b_router": 0.01 * jax.random.normal(ks[16], (DEPTH, G * E), f32),
        "w1": nrm(ks[17], (DEPTH, G, E, D, F), D),
        "w3": nrm(ks[18], (DEPTH, G, E, D, F), D),
        "w2": nrm(ks[19], (DEPTH, G, E, F, D), F),
    }


def reference(x, meta_tokens, norm_mix_g, w_in, b_forget, q_norm_g, k_norm_g, w_up_attn,
              w_pool, pool_scale, w_up_pool, w_out, norm_ffn_g, w_group, b_group, w_router,
              b_router, w1, w3, w2):
    B = x.shape[0]
    meta = jnp.broadcast_to(meta_tokens.astype(x.dtype)[None], (B, N_META, D_MODEL))
    h = jnp.concatenate([meta, x], axis=1)
    L = h.shape[1]
    for l in range(DEPTH):
        hn = rmsnorm(h, norm_mix_g[l])
        proj = hn @ w_in[l]
        q = rmsnorm(proj[..., Q_OFF:K_OFF].reshape(B, L, N_HEADS, HEAD_DIM), q_norm_g[l])
        k = rmsnorm(proj[..., K_OFF:V_OFF].reshape(B, L, N_HEADS, HEAD_DIM), k_norm_g[l])
        v = proj[..., V_OFF:F_OFF].reshape(B, L, N_HEADS, HEAD_DIM)
        log_f = jax.nn.log_sigmoid(proj[..., F_OFF:P_OFF].astype(jnp.float32)
                                   + b_forget[l].astype(jnp.float32))
        fcum = jnp.cumsum(log_f, axis=1).transpose(0, 2, 1)
        o = forgetting_attention(q.transpose(0, 2, 1, 3), k.transpose(0, 2, 1, 3),
                                 v.transpose(0, 2, 1, 3), fcum)
        y_attn = o.transpose(0, 2, 1, 3).reshape(B, L, ATTN_WIDTH) @ w_up_attn[l]
        y_pool = multiscale_pool(proj[..., P_OFF:G_OFF], w_pool[l], pool_scale[l]) @ w_up_pool[l]
        gates = jax.nn.sigmoid(proj[..., G_OFF:].astype(jnp.float32)).astype(h.dtype)
        gates = gates.reshape(B, L, N_BRANCHES, D_MODEL)
        merged = gates[:, :, 0] * y_attn + gates[:, :, 1] * y_pool
        h = h + merged @ w_out[l]
        hn = rmsnorm(h, norm_ffn_g[l]).reshape(B * L, D_MODEL)
        y_ffn = hierarchical_moe(hn, w_group[l], b_group[l], w_router[l], b_router[l],
                                 w1[l], w3[l], w2[l])
        h = h + y_ffn.reshape(B, L, D_MODEL)
    return h[:, N_META:]
```

```cpp
#include <hip/hip_runtime.h>
#include <hip/hip_cooperative_groups.h>
#include <hip/hip_bf16.h>
#include <cstdio>
#include <cstdint>
#include <cmath>
namespace cg = cooperative_groups;

constexpr int DM_ = 1024, NBATCH = 8, SEQ_ = 4096, MX = NBATCH * SEQ_;
constexpr int NMETA = 16, LP = 4160, KVR = NBATCH * LP;
constexpr int NHEAD_ = 8, HD_ = 64, AW = 512, PW = 512, NMAIN = 4096;
constexpr int NEXP = 32, FH = 256, LCAP = 32768;
constexpr float RMS_EPS = 1e-6f;
constexpr float LOG2E = 1.4426950408889634f;
constexpr float C2 = 0.125f * LOG2E;

constexpr size_t MiB = 1u << 20;
constexpr size_t WS_CTL = 0, CTL_BYTES = 65536;
constexpr size_t WS_WMAIN = 2 * MiB, WS_WA = 10 * MiB, WS_WE = 11 * MiB, WS_WOUT = 12 * MiB, WS_WR = 14 * MiB, WS_HNM = 15 * MiB;
constexpr size_t WS_LF = 16 * MiB, WS_SSQ = 18 * MiB, WS_W13 = 20 * MiB, WS_W2 = 52 * MiB;
constexpr size_t WS_TOK = 68 * MiB, WS_RS = 76 * MiB, WS_CW = 84 * MiB;
constexpr size_t WS_RA = 96 * MiB;
constexpr size_t WS_RB = 160 * MiB;
constexpr size_t WS_Q = 288 * MiB, WS_K = 320 * MiB, WS_V = 353 * MiB, WS_U = 386 * MiB;
constexpr size_t WS_MG = 288 * MiB;
constexpr size_t WS_O = 420 * MiB, WS_MIX = 452 * MiB, WS_END = 484 * MiB;
constexpr int CW_CNT = 0;

#ifndef PH_MASK
#define PH_MASK 0xffff
#endif
#define PH(k) ((PH_MASK >> (k)) & 1)
#ifndef DBG_STOP
#define DBG_STOP 0
#endif
constexpr int RING_BYTES = 131072, LDSX_OFF = RING_BYTES, LDS_BYTES = 147456;

#define LAS __attribute__((address_space(3)))
typedef unsigned short bf16_t;
typedef short bf16x8 __attribute__((ext_vector_type(8)));
typedef float f32x4 __attribute__((ext_vector_type(4)));
typedef float f32x2 __attribute__((ext_vector_type(2)));
typedef unsigned u32x4 __attribute__((ext_vector_type(4)));
typedef unsigned u32x2 __attribute__((ext_vector_type(2)));

typedef __bf16 bf16x2_v __attribute__((ext_vector_type(2)));
__device__ __forceinline__ unsigned cvt_pk_bf16(float lo, float hi) { f32x2 v = {lo, hi}; bf16x2_v b = __builtin_convertvector(v, bf16x2_v); return __builtin_bit_cast(unsigned, b); }
__device__ __forceinline__ float bf_lo(unsigned w) { return __uint_as_float(w << 16); }
__device__ __forceinline__ float bf_hi(unsigned w) { return __uint_as_float(w & 0xffff0000u); }
__device__ __forceinline__ float fast_sigmoid(float x) { return __builtin_amdgcn_rcpf(1.0f + __builtin_amdgcn_exp2f(-x * LOG2E)); }
__device__ __forceinline__ int lane_id() { int l = (int)__builtin_amdgcn_mbcnt_hi(~0u, __builtin_amdgcn_mbcnt_lo(~0u, 0u)); asm volatile("" : "+v"(l)); return l; }
__device__ __forceinline__ float wave_sum(float v) {
#pragma unroll
    for (int o = 1; o < 64; o <<= 1) v += __shfl_xor(v, o);
    return v;
}

namespace pg8 {
constexpr int BM = 256, BK = 64, HALF = 128, HTB = HALF * BK * 2, NXCD = 8, WGM = 8;
__host__ __device__ __forceinline__ int lds_byte(int r, int c) { const int st = (r >> 4) * 2 + (c >> 5), rr = r & 15, cc = c & 31, ob = rr * 64 + cc * 2; return st * 1024 + (ob ^ (((ob >> 9) & 1) << 5)); }
__host__ __device__ __forceinline__ void stage_rc(int b, int& R, int& C) { const int st = b / 1024, sb = b % 1024, swz = sb ^ (((sb >> 9) & 1) << 5); R = (st >> 1) * 16 + swz / 64; C = (st & 1) * 32 + (swz % 64) / 2; }
__host__ __device__ __forceinline__ int perm32(int rho) { const int n = rho >> 4, i = rho & 15; return 8 * (i >> 2) + 4 * n + (i & 3); }

struct Unit { const char* a; const char* b; const int* tok; int pm, pn, cnt, aux, hrow; };

struct GridOrder {
    int nM, nN, nwg, G, c; const char* A; const char* B; size_t tsA, tsB;
    __device__ void init(const void* A_, const void* B_, int M, int N, int K, int G_, int c_) { nM = M / BM; nN = N / BM; nwg = nM * nN; G = G_; c = c_; A = (const char*)A_; B = (const char*)B_; tsA = (size_t)BM * K * 2; tsB = tsA; }
    __device__ bool next(int i, Unit& u) const {
        const long L = (long)i * G + c; if (L >= nwg) return false;
        int wgid = (int)L; { const int q = nwg / NXCD, r = nwg % NXCD, xcd = wgid % NXCD, off = wgid / NXCD; wgid = (xcd < r ? xcd * (q + 1) : r * (q + 1) + (xcd - r) * q) + off; }
        const int nig = WGM * nN, gid = wgid / nig, fm = gid * WGM, gsz = (nM - fm) < WGM ? (nM - fm) : WGM;
        u.pm = fm + ((wgid % nig) % gsz); u.pn = (wgid % nig) / gsz; u.a = A + (size_t)u.pm * tsA; u.b = B + (size_t)u.pn * tsB; u.tok = nullptr; u.cnt = 256; u.aux = 0; u.hrow = 0; return true;
    }
};

template <class Epi, class Sched, bool GATHER>
__device__ __forceinline__ void gemm_phase(LAS unsigned char* lds, const int K, const Sched& S, const Epi& E, const int wave_s) {
    int tid_ = wave_s * 64 + lane_id(); asm volatile("" : "+v"(tid_));
    const int tid = tid_, wid = wave_s, lane = tid & 63, wr = wid >> 2, wc = wid & 3, fr = lane & 15, fq = lane >> 4;
    const int nt = K / BK;
    int Rr[2], Cc[2]; unsigned voffB[2];
#pragma unroll
    for (int i = 0; i < 2; ++i) { stage_rc(tid * 16 + i * 8192, Rr[i], Cc[i]); const int Rb = (Rr[i] & ~31) + perm32(Rr[i] & 31); voffB[i] = (unsigned)(Rb * K + Cc[i]) * 2u; }
    const size_t kstep = (size_t)(BK * 2);
    const size_t hstep = (size_t)HALF * K * 2;
    const unsigned ldsw = (unsigned)wid * 1024u;
    const int aoff = lds_byte(wr * 64 + fr, fq * 8), boff = lds_byte(wc * 32 + fr, fq * 8);
#define PG8_SA(b, h) (((b) * 2 + (h)) * HTB)
#define PG8_SB(b, h) ((4 + (b) * 2 + (h)) * HTB)
#define PG8_STAGE(bufoff, gbase, voff) do { _Pragma("unroll") for (int _i = 0; _i < 2; ++_i) \
        __builtin_amdgcn_global_load_lds((const unsigned*)((const char*)(gbase) + (voff)[_i]), (LAS unsigned*)(lds + (bufoff) + ldsw + _i * 8192), 16, 0, 0); } while (0)
#define PG8_LDA(dst, b, h) do { _Pragma("unroll") for (int m = 0; m < 4; ++m) _Pragma("unroll") for (int k = 0; k < 2; ++k) dst[m][k] = *(const LAS bf16x8*)(lds + PG8_SA(b, h) + aoff + m * 2048 + k * 1024); } while (0)
#define PG8_LDB(dst, b, h) do { _Pragma("unroll") for (int n = 0; n < 2; ++n) _Pragma("unroll") for (int k = 0; k < 2; ++k) dst[n][k] = *(const LAS bf16x8*)(lds + PG8_SB(b, h) + boff + n * 2048 + k * 1024); } while (0)
#define PG8_MMA(ai, bj, At, Bt) do { __builtin_amdgcn_s_setprio(1); _Pragma("unroll") for (int m = 0; m < 4; ++m) _Pragma("unroll") for (int n = 0; n < 2; ++n) _Pragma("unroll") for (int k = 0; k < 2; ++k) \
        acc[ai][bj][m][n] = __builtin_amdgcn_mfma_f32_16x16x32_bf16(Bt[n][k], At[m][k], acc[ai][bj][m][n], 0, 0, 0); __builtin_amdgcn_s_setprio(0); } while (0)
#define PG8_WAIT_V(n) asm volatile("s_waitcnt vmcnt(" #n ")" ::: "memory")
#define PG8_WAIT_L(n) asm volatile("s_waitcnt lgkmcnt(" #n ")" ::: "memory")
#define PG8_BAR __builtin_amdgcn_s_barrier()
#define PG8_SCHED __builtin_amdgcn_sched_barrier(0)
#define PG8_SETA(v, u) do { _Pragma("unroll") for (int _h = 0; _h < 2; ++_h) _Pragma("unroll") for (int _i = 0; _i < 2; ++_i) { const int _row = Rr[_i] + 128 * _h; \
        int _t = _row; if (GATHER) { _t = (_row < (u).cnt) ? (u).tok[_row] : 0; } v[_h][_i] = (unsigned)(_t * K + Cc[_i]) * 2u; } } while (0)
    Unit cur, nxt; int ui = 0;
    if (!S.next(0, cur)) return;
    f32x4 acc[2][2][4][2];
#pragma unroll
    for (int a = 0; a < 2; ++a)
#pragma unroll
        for (int b = 0; b < 2; ++b)
#pragma unroll
            for (int m = 0; m < 4; ++m)
#pragma unroll
                for (int n = 0; n < 2; ++n) acc[a][b][m][n] = (f32x4){0.f, 0.f, 0.f, 0.f};
    bf16x8 At[4][2], B0[2][2], B1[2][2];
    unsigned cvA[2][2], nvA[2][2];
    PG8_SETA(cvA, cur);
    const char* cA = cur.a; const char* cB = cur.b;
    PG8_STAGE(PG8_SB(0, 0), cB, voffB); PG8_STAGE(PG8_SB(0, 1), cB + hstep, voffB); PG8_STAGE(PG8_SA(0, 0), cA, cvA[0]); PG8_STAGE(PG8_SA(0, 1), cA, cvA[1]);
    if (wr == 1) PG8_BAR;
    PG8_WAIT_V(2); PG8_BAR;
    PG8_STAGE(PG8_SB(1, 0), cB + kstep, voffB); PG8_STAGE(PG8_SA(1, 0), cA + kstep, cvA[0]); PG8_STAGE(PG8_SB(1, 1), cB + hstep + kstep, voffB);
    PG8_WAIT_V(6); PG8_BAR;
    for (;;) {
        const bool has_next = S.next(ui + 1, nxt);
        if (has_next) { PG8_SETA(nvA, nxt); } else {
#pragma unroll
            for (int h = 0; h < 2; ++h)
#pragma unroll
                for (int i = 0; i < 2; ++i) nvA[h][i] = cvA[h][i]; }
        const char* nA = has_next ? nxt.a : cA; const char* nB = has_next ? nxt.b : cB;
        for (int t = 0; t < nt; t += 2) {
            const bool last = (t == nt - 2);
            const char* a1 = cA + (size_t)(t + 1) * kstep;
            const char* a2 = last ? nA : cA + (size_t)(t + 2) * kstep; const char* b2 = last ? nB : cB + (size_t)(t + 2) * kstep;
            const char* a3 = a2 + kstep; const char* b3 = b2 + kstep;
            unsigned xv[2][2];
#pragma unroll
            for (int h = 0; h < 2; ++h)
#pragma unroll
                for (int i = 0; i < 2; ++i) xv[h][i] = last ? nvA[h][i] : cvA[h][i];
            PG8_LDB(B0, 0, 0); PG8_LDB(B1, 0, 1); PG8_SCHED; PG8_LDA(At, 0, 0); PG8_STAGE(PG8_SA(1, 1), a1, cvA[1]);
            PG8_WAIT_V(8); PG8_WAIT_L(0); PG8_BAR; PG8_MMA(0, 0, At, B0); PG8_MMA(0, 1, At, B1); PG8_BAR; PG8_SCHED;
            PG8_LDA(At, 0, 1); PG8_STAGE(PG8_SB(0, 0), b2, voffB); PG8_STAGE(PG8_SB(0, 1), b2 + hstep, voffB); PG8_STAGE(PG8_SA(0, 0), a2, xv[0]);
            PG8_WAIT_V(8); PG8_WAIT_L(0); PG8_BAR; PG8_MMA(1, 0, At, B0); PG8_MMA(1, 1, At, B1); PG8_BAR; PG8_SCHED;
            PG8_LDB(B0, 1, 0); PG8_LDB(B1, 1, 1); PG8_SCHED; PG8_LDA(At, 1, 0); PG8_STAGE(PG8_SA(0, 1), a2, xv[1]);
            PG8_WAIT_V(8); PG8_WAIT_L(0); PG8_BAR; PG8_MMA(0, 0, At, B0); PG8_MMA(0, 1, At, B1); PG8_BAR; PG8_SCHED;
            PG8_LDA(At, 1, 1); PG8_STAGE(PG8_SB(1, 0), b3, voffB); PG8_STAGE(PG8_SB(1, 1), b3 + hstep, voffB); PG8_STAGE(PG8_SA(1, 0), a3, xv[0]);
            PG8_WAIT_V(8); PG8_WAIT_L(0); PG8_BAR; PG8_MMA(1, 0, At, B0); PG8_MMA(1, 1, At, B1); PG8_BAR; PG8_SCHED;
        }
        if (wr == 0) PG8_BAR;
        E(acc, cur, wr, wc, fr, fq);
        if (!has_next) break;
#pragma unroll
        for (int a = 0; a < 2; ++a)
#pragma unroll
            for (int b = 0; b < 2; ++b)
#pragma unroll
                for (int m = 0; m < 4; ++m)
#pragma unroll
                    for (int n = 0; n < 2; ++n) acc[a][b][m][n] = (f32x4){0.f, 0.f, 0.f, 0.f};
        cur = nxt; cA = nA; cB = nB; ++ui;
#pragma unroll
        for (int h = 0; h < 2; ++h)
#pragma unroll
            for (int i = 0; i < 2; ++i) cvA[h][i] = nvA[h][i];
        if (wr == 1) PG8_BAR;
    }
    PG8_WAIT_V(0);
    PG8_BAR;
#undef PG8_SA
#undef PG8_SB
#undef PG8_STAGE
#undef PG8_LDA
#undef PG8_LDB
#undef PG8_MMA
#undef PG8_WAIT_V
#undef PG8_WAIT_L
#undef PG8_BAR
#undef PG8_SCHED
#undef PG8_SETA
}
}

typedef f32x4 AccT[2][2][4][2];

struct EpiInProj {
    bf16_t *Q, *Kp, *Vp, *Up, *G; const float *gq, *gk;
    __device__ __forceinline__ void operator()(const AccT& acc, const pg8::Unit& u, int wr, int wc, int fr, int fq) const {
        const int pn = u.pn, pm = u.pm, b = pm >> 4;
        const int row0 = pm * 256 + wr * 64 + fr, prow0 = row0 + 64 * (b + 1);
        const int d0 = 8 * fq;
        if (pn < 4) {
            const bool isq = pn < 2; const float* gv = isq ? gq : gk; const float sc = isq ? C2 : 1.0f;
            float g0[8], g1[8];
#pragma unroll
            for (int i = 0; i < 8; ++i) { g0[i] = gv[d0 + i] * sc; g1[i] = gv[32 + d0 + i] * sc; }
            bf16_t* base = (isq ? Q + (size_t)row0 * 512 : Kp + (size_t)prow0 * 512) + 64 * (4 * (pn & 1) + wc) + d0;
#pragma unroll
            for (int ai = 0; ai < 2; ++ai)
#pragma unroll
                for (int m = 0; m < 4; ++m) {
                    const f32x4 v00 = acc[ai][0][m][0], v01 = acc[ai][0][m][1], v10 = acc[ai][1][m][0], v11 = acc[ai][1][m][1];
                    float ss = 0.f;
#pragma unroll
                    for (int i = 0; i < 4; ++i) ss += v00[i] * v00[i] + v01[i] * v01[i] + v10[i] * v10[i] + v11[i] * v11[i];
                    ss += __shfl_xor(ss, 16); ss += __shfl_xor(ss, 32);
                    const float r = __builtin_amdgcn_rsqf(ss * (1.0f / 64.0f) + RMS_EPS);
                    bf16_t* rowp = base + (size_t)(ai * 128 + m * 16) * 512;
                    u32x4 w0, w1;
                    w0.x = cvt_pk_bf16(v00[0] * r * g0[0], v00[1] * r * g0[1]); w0.y = cvt_pk_bf16(v00[2] * r * g0[2], v00[3] * r * g0[3]);
                    w0.z = cvt_pk_bf16(v01[0] * r * g0[4], v01[1] * r * g0[5]); w0.w = cvt_pk_bf16(v01[2] * r * g0[6], v01[3] * r * g0[7]);
                    w1.x = cvt_pk_bf16(v10[0] * r * g1[0], v10[1] * r * g1[1]); w1.y = cvt_pk_bf16(v10[2] * r * g1[2], v10[3] * r * g1[3]);
                    w1.z = cvt_pk_bf16(v11[0] * r * g1[4], v11[1] * r * g1[5]); w1.w = cvt_pk_bf16(v11[2] * r * g1[6], v11[3] * r * g1[7]);
                    *(u32x4*)(rowp) = w0; *(u32x4*)(rowp + 32) = w1;
                }
        } else if (pn < 8) {
            bf16_t* base = (pn < 6 ? Vp : Up) + (size_t)prow0 * 512 + 64 * (4 * (pn & 1) + wc) + d0;
#pragma unroll
            for (int ai = 0; ai < 2; ++ai)
#pragma unroll
                for (int m = 0; m < 4; ++m) { bf16_t* rowp = base + (size_t)(ai * 128 + m * 16) * 512;
#pragma unroll
                    for (int bj = 0; bj < 2; ++bj) { const f32x4 v0 = acc[ai][bj][m][0], v1 = acc[ai][bj][m][1]; u32x4 w;
                        w.x = cvt_pk_bf16(v0[0], v0[1]); w.y = cvt_pk_bf16(v0[2], v0[3]); w.z = cvt_pk_bf16(v1[0], v1[1]); w.w = cvt_pk_bf16(v1[2], v1[3]);
                        *(u32x4*)(rowp + 32 * bj) = w; } }
        } else {
            bf16_t* base = G + (size_t)row0 * 2048 + 256 * (pn - 8) + 64 * wc + d0;
#pragma unroll
            for (int ai = 0; ai < 2; ++ai)
#pragma unroll
                for (int m = 0; m < 4; ++m) { bf16_t* rowp = base + (size_t)(ai * 128 + m * 16) * 2048;
#pragma unroll
                    for (int bj = 0; bj < 2; ++bj) { const f32x4 v0 = acc[ai][bj][m][0], v1 = acc[ai][bj][m][1]; u32x4 w;
                        w.x = cvt_pk_bf16(fast_sigmoid(v0[0]), fast_sigmoid(v0[1])); w.y = cvt_pk_bf16(fast_sigmoid(v0[2]), fast_sigmoid(v0[3]));
                        w.z = cvt_pk_bf16(fast_sigmoid(v1[0]), fast_sigmoid(v1[1])); w.w = cvt_pk_bf16(fast_sigmoid(v1[2]), fast_sigmoid(v1[3]));
                        *(u32x4*)(rowp + 32 * bj) = w; } }
        }
    }
};
template <bool ADD> struct EpiGate {
    bf16_t* out; const bf16_t* gate; const bf16_t* add;
    __device__ __forceinline__ void operator()(const AccT& acc, const pg8::Unit& u, int wr, int wc, int fr, int fq) const {
        const int row0 = u.pm * 256 + wr * 64 + fr, col0 = u.pn * 256 + wc * 32 + 8 * fq;
#pragma unroll
        for (int ai = 0; ai < 2; ++ai) {
            u32x4 gv[4][2], av[4][2];
#pragma unroll
            for (int m = 0; m < 4; ++m)
#pragma unroll
                for (int bj = 0; bj < 2; ++bj) { const size_t r = (size_t)(row0 + ai * 128 + m * 16); gv[m][bj] = *(const u32x4*)(gate + r * 2048 + col0 + bj * 128); if (ADD) av[m][bj] = *(const u32x4*)(add + r * 1024 + col0 + bj * 128); }
#pragma unroll
            for (int m = 0; m < 4; ++m)
#pragma unroll
                for (int bj = 0; bj < 2; ++bj) { const size_t r = (size_t)(row0 + ai * 128 + m * 16); const f32x4 v0 = acc[ai][bj][m][0], v1 = acc[ai][bj][m][1]; const u32x4 g = gv[m][bj];
                    float o[8] = {v0[0] * bf_lo(g.x), v0[1] * bf_hi(g.x), v0[2] * bf_lo(g.y), v0[3] * bf_hi(g.y), v1[0] * bf_lo(g.z), v1[1] * bf_hi(g.z), v1[2] * bf_lo(g.w), v1[3] * bf_hi(g.w)};
                    if (ADD) { const u32x4 a = av[m][bj]; o[0] += bf_lo(a.x); o[1] += bf_hi(a.x); o[2] += bf_lo(a.y); o[3] += bf_hi(a.y); o[4] += bf_lo(a.z); o[5] += bf_hi(a.z); o[6] += bf_lo(a.w); o[7] += bf_hi(a.w); }
                    u32x4 w; w.x = cvt_pk_bf16(o[0], o[1]); w.y = cvt_pk_bf16(o[2], o[3]); w.z = cvt_pk_bf16(o[4], o[5]); w.w = cvt_pk_bf16(o[6], o[7]);
                    *(u32x4*)(out + r * 1024 + col0 + bj * 128) = w; }
        }
    }
};
struct EpiResid {
    const float* x; float* h1; bf16_t* h1b; float* ssq;
    __device__ __forceinline__ void operator()(const AccT& acc, const pg8::Unit& u, int wr, int wc, int fr, int fq) const {
        const int row0 = u.pm * 256 + wr * 64 + fr, col0 = u.pn * 256 + wc * 32 + 8 * fq;
#pragma unroll
        for (int ai = 0; ai < 2; ++ai) {
            f32x4 xv[4][2][2];
#pragma unroll
            for (int m = 0; m < 4; ++m)
#pragma unroll
                for (int bj = 0; bj < 2; ++bj) { const float* p = x + (size_t)(row0 + ai * 128 + m * 16) * 1024 + col0 + bj * 128; xv[m][bj][0] = *(const f32x4*)p; xv[m][bj][1] = *(const f32x4*)(p + 4); }
#pragma unroll
            for (int m = 0; m < 4; ++m) { const size_t r = (size_t)(row0 + ai * 128 + m * 16); float ss = 0.f;
#pragma unroll
                for (int bj = 0; bj < 2; ++bj) { const f32x4 v0 = acc[ai][bj][m][0] + xv[m][bj][0], v1 = acc[ai][bj][m][1] + xv[m][bj][1];
                    ss += (v0[0] * v0[0] + v0[1] * v0[1]) + (v0[2] * v0[2] + v0[3] * v0[3]) + (v1[0] * v1[0] + v1[1] * v1[1]) + (v1[2] * v1[2] + v1[3] * v1[3]);
                    float* p = h1 + r * 1024 + col0 + bj * 128; *(f32x4*)p = v0; *(f32x4*)(p + 4) = v1;
                    u32x4 w; w.x = cvt_pk_bf16(v0[0], v0[1]); w.y = cvt_pk_bf16(v0[2], v0[3]); w.z = cvt_pk_bf16(v1[0], v1[1]); w.w = cvt_pk_bf16(v1[2], v1[3]);
                    *(u32x4*)(h1b + r * 1024 + col0 + bj * 128) = w; }
                ss += __shfl_xor(ss, 16); ss += __shfl_xor(ss, 32);
                if (fq == 0) ssq[r * 16 + u.pn * 4 + wc] = ss; }
        }
    }
};
struct EpiSwiGLU {
    bf16_t* HH; const float* rs; const float* cw;
    __device__ __forceinline__ void operator()(const AccT& acc, const pg8::Unit& u, int wr, int wc, int fr, int fq) const {
        const int lr0 = wr * 64 + fr, col0 = u.pn * 128 + wc * 32 + 8 * fq;
#pragma unroll
        for (int ai = 0; ai < 2; ++ai)
#pragma unroll
            for (int m = 0; m < 4; ++m) { const int lr = lr0 + ai * 128 + m * 16; const bool valid = lr < u.cnt;
                const float r = valid ? rs[u.aux + lr] : 0.f, c = valid ? cw[u.aux + lr] : 0.f;
                float o[8];
#pragma unroll
                for (int n = 0; n < 2; ++n)
#pragma unroll
                    for (int i = 0; i < 4; ++i) { const float a1 = acc[ai][0][m][n][i] * r, a3 = acc[ai][1][m][n][i] * r; o[4 * n + i] = a1 * fast_sigmoid(a1) * a3 * c; }
                u32x4 w; w.x = cvt_pk_bf16(o[0], o[1]); w.y = cvt_pk_bf16(o[2], o[3]); w.z = cvt_pk_bf16(o[4], o[5]); w.w = cvt_pk_bf16(o[6], o[7]);
                *(u32x4*)(HH + (size_t)(u.hrow + lr) * 256 + col0) = w; }
    }
};
struct EpiScatter {
    float* out; const int* tok;
    __device__ __forceinline__ void operator()(const AccT& acc, const pg8::Unit& u, int wr, int wc, int fr, int fq) const {
        const int lr0 = wr * 64 + fr, col0 = u.pn * 256 + wc * 32 + 8 * fq;
#pragma unroll
        for (int ai = 0; ai < 2; ++ai)
#pragma unroll
            for (int mp = 0; mp < 2; ++mp) {
                int tk[2]; bool ok[2]; f32x4 ov[2][2][2];
#pragma unroll
                for (int q = 0; q < 2; ++q) { const int lr = lr0 + ai * 128 + (2 * mp + q) * 16; ok[q] = lr < u.cnt; tk[q] = ok[q] ? tok[u.aux + lr] : 0; }
#pragma unroll
                for (int q = 0; q < 2; ++q)
#pragma unroll
                    for (int bj = 0; bj < 2; ++bj) { const float* p = out + (size_t)tk[q] * 1024 + col0 + bj * 128; ov[q][bj][0] = *(const f32x4*)p; ov[q][bj][1] = *(const f32x4*)(p + 4); }
#pragma unroll
                for (int q = 0; q < 2; ++q) if (ok[q]) {
#pragma unroll
                    for (int bj = 0; bj < 2; ++bj) { float* p = out + (size_t)tk[q] * 1024 + col0 + bj * 128; *(f32x4*)p = ov[q][bj][0] + acc[ai][bj][2 * mp + q][0]; *(f32x4*)(p + 4) = ov[q][bj][1] + acc[ai][bj][2 * mp + q][1]; } }
            }
    }
};

template <int NSUB, bool G1> struct MoeOrder {
    const volatile LAS int* pre; const volatile LAS int* cnt; int l0, nl, G, c; const char* A; const char* W; const int* tok;
    __device__ bool next(int i, pg8::Unit& u) const {
        const int id = i * G + c; const int t0 = __builtin_amdgcn_readfirstlane(pre[l0]), total = (__builtin_amdgcn_readfirstlane(pre[l0 + nl]) - t0) * NSUB; if (id >= total) return false;
        const int tile = t0 + id / NSUB, sub = id % NSUB; int l = l0; while (tile >= pre[l + 1]) ++l;
        l = __builtin_amdgcn_readfirstlane(l);
        const int mt = __builtin_amdgcn_readfirstlane(tile - pre[l]), e = l & 31;
        u.pm = mt; u.pn = sub; u.cnt = __builtin_amdgcn_readfirstlane(min(256, cnt[l] - mt * 256)); u.aux = l * LCAP + mt * 256; u.hrow = tile * 256; u.tok = tok + u.aux;
        if (G1) { u.a = A; u.b = W + ((size_t)e * 512 + (size_t)sub * 256) * 1024 * 2; }
        else    { u.a = A + (size_t)tile * 256 * 256 * 2; u.b = W + ((size_t)e * 1024 + (size_t)sub * 256) * 256 * 2; }
        return true;
    }
};

namespace attn_body {
using bf16 = __hip_bfloat16;
using bf16x8 = __attribute__((ext_vector_type(8))) short;
using s16x4 = __attribute__((ext_vector_type(4))) short;
using f32x16 = __attribute__((ext_vector_type(16))) float;
using u32x4 = __attribute__((ext_vector_type(4))) unsigned;
constexpr int D = 64, DM = 512;
constexpr int NW = 8, QBLK = 32, QB = QBLK * NW, KVBLK = 64;
__device__ __forceinline__ int crow(int r, int hi) { return (r & 3) + 8 * (r >> 2) + 4 * hi; }
#define SBAR() __builtin_amdgcn_sched_barrier(0)
__device__ __forceinline__ void cmask(f32x16& p0, f32x16& p1, int jb, int qrel, int hi) {
    const float NEG = -INFINITY; int kb = 64 * jb + 4 * hi;
#pragma unroll
    for (int r = 0; r < 16; ++r) { int kv = kb + (r & 3) + 8 * (r >> 2); if (kv > qrel) p0[r] = NEG; if (kv + 32 > qrel) p1[r] = NEG; }
}
constexpr int NSLOT = 3, SLOTB = 8192;
constexpr int LDS_K = 0, LDS_V = NSLOT * SLOTB, LDS_WS = 2 * NSLOT * SLOTB, LDS_OST = LDS_WS + NW * 64 * 4, LDS_KB = LDS_OST + NW * 4096, LDS_BYTES = LDS_KB + LP * 4;
__device__ __forceinline__ void glds16(const void* gsrc, unsigned lds_dst) { unsigned keep;
    asm volatile("s_mov_b32 %0, m0\n\ts_mov_b32 m0, %2\n\ts_nop 0\n\tglobal_load_lds_dwordx4 %1, off\n\ts_mov_b32 m0, %0" : "=&s"(keep) : "v"(gsrc), "s"(lds_dst) : "memory"); }
__device__ __forceinline__ float max3f(float a, float b, float c) { float r; asm("v_max3_f32 %0, %1, %2, %3" : "=v"(r) : "v"(a), "v"(b), "v"(c)); return r; }
__device__ __forceinline__ float max2f(float a, float b) { float r; asm("v_max_f32_e32 %0, %1, %2" : "=v"(r) : "v"(a), "v"(b)); return r; }
__device__ __forceinline__ float fsub_s(float a, float b) { float r; asm("v_sub_f32_e32 %0, %1, %2" : "=v"(r) : "v"(a), "v"(b)); return r; }
typedef float f32x2_t __attribute__((ext_vector_type(2))); typedef __bf16 bf16x2_t __attribute__((ext_vector_type(2)));
__device__ __forceinline__ unsigned cvtpk_s(float lo, float hi) { f32x2_t v = {lo, hi}; bf16x2_t b = __builtin_convertvector(v, bf16x2_t); return __builtin_bit_cast(unsigned, b); }
#define WAIT_BAR(N) asm volatile("s_waitcnt vmcnt(" #N ") lgkmcnt(0)\n\ts_barrier" ::: "memory")
typedef __attribute__((address_space(3))) const char* lds_cptr;
typedef __attribute__((address_space(3))) const float* lds_fptr;
typedef short v4i16_t __attribute__((ext_vector_type(4)));
__device__ __forceinline__ void cinit(f32x16& c0, f32x16& c1, lds_fptr kb, float nref, int hi) {
#pragma unroll
    for (int g = 0; g < 4; ++g) { const f32x4 a = *(const LAS f32x4*)(kb + 8 * g + 4 * hi), b = *(const LAS f32x4*)(kb + 32 + 8 * g + 4 * hi);
#pragma unroll
        for (int i = 0; i < 4; ++i) { c0[4 * g + i] = a[i] + nref; c1[4 * g + i] = b[i] + nref; } }
}
__device__ __forceinline__ void qkt(f32x16& p0, f32x16& p1, const char* Kslot, const bf16x8* qr, const f32x16& c0, const f32x16& c1, int r32, int hi) {
    const char* kb = Kslot + hi * 1024 + r32 * 16;
#pragma unroll
    for (int d0 = 0; d0 < 4; ++d0) {
        const bf16x8 b0 = *reinterpret_cast<const bf16x8*>(kb + d0 * 2048);
        const bf16x8 b1 = *reinterpret_cast<const bf16x8*>(kb + d0 * 2048 + 512);
        if (d0 == 0) { p0 = __builtin_amdgcn_mfma_f32_32x32x16_bf16(b0, qr[0], c0, 0, 0, 0); p1 = __builtin_amdgcn_mfma_f32_32x32x16_bf16(b1, qr[0], c1, 0, 0, 0); }
        else { p0 = __builtin_amdgcn_mfma_f32_32x32x16_bf16(b0, qr[d0], p0, 0, 0, 0); p1 = __builtin_amdgcn_mfma_f32_32x32x16_bf16(b1, qr[d0], p1, 0, 0, 0); } }
}
__device__ __forceinline__ void kload8(bf16x8* kf, lds_cptr kp) {
    kf[0] = *(const LAS bf16x8*)(kp);        kf[1] = *(const LAS bf16x8*)(kp + 512);
    kf[2] = *(const LAS bf16x8*)(kp + 2048); kf[3] = *(const LAS bf16x8*)(kp + 2560);
    kf[4] = *(const LAS bf16x8*)(kp + 4096); kf[5] = *(const LAS bf16x8*)(kp + 4608);
    kf[6] = *(const LAS bf16x8*)(kp + 6144); kf[7] = *(const LAS bf16x8*)(kp + 6656);
}
__device__ __forceinline__ void kload2(bf16x8* kf, lds_cptr kp, int j) { kf[2 * j] = *(const LAS bf16x8*)(kp + j * 2048); kf[2 * j + 1] = *(const LAS bf16x8*)(kp + j * 2048 + 512); }
__device__ __forceinline__ s16x4 vtr(lds_cptr p) { return __builtin_bit_cast(s16x4, __builtin_amdgcn_ds_read_tr16_b64_v4i16((LAS v4i16_t*)p)); }
__device__ __forceinline__ float rowmax(const f32x16& p0, const f32x16& p1) {
    float a = max3f(p0[0], p0[1], p1[0]), b = max3f(p0[2], p0[3], p1[1]); a = max3f(a, p1[2], p1[3]);
#pragma unroll
    for (int r = 4; r < 16; r += 4) { a = max3f(a, p0[r], p0[r + 1]); b = max3f(b, p0[r + 2], p0[r + 3]); a = max3f(a, p1[r], p1[r + 1]); b = max3f(b, p1[r + 2], p1[r + 3]); }
    const float m = max2f(a, b);
    auto rr = __builtin_amdgcn_permlane32_swap(__float_as_uint(m), __float_as_uint(m), false, false);
    return max2f(__uint_as_float(rr[0]), __uint_as_float(rr[1]));
}
__device__ __forceinline__ void pv(f32x16* o, int vb, bf16x8 pa0, bf16x8 pa1, bf16x8 pa2, bf16x8 pa3) {
#pragma unroll
    for (int d0 = 0; d0 < 2; ++d0) { s16x4 lo[4], hi[4];
#pragma unroll
        for (int ks = 0; ks < 4; ++ks) {
            asm volatile("ds_read_b64_tr_b16 %0,%1 offset:%c2" : "=&v"(lo[ks]) : "v"(vb), "i"(d0 * 4096 + ks * 1024) : "memory");
            asm volatile("ds_read_b64_tr_b16 %0,%1 offset:%c2" : "=&v"(hi[ks]) : "v"(vb), "i"(d0 * 4096 + ks * 1024 + 512) : "memory"); }
        asm volatile("s_waitcnt lgkmcnt(0)" ::: "memory"); SBAR();
#define PK(k) (bf16x8){lo[k][0], lo[k][1], lo[k][2], lo[k][3], hi[k][0], hi[k][1], hi[k][2], hi[k][3]}
        o[d0] = __builtin_amdgcn_mfma_f32_32x32x16_bf16(pa0, PK(0), o[d0], 0, 0, 0);
        o[d0] = __builtin_amdgcn_mfma_f32_32x32x16_bf16(pa1, PK(1), o[d0], 0, 0, 0);
        o[d0] = __builtin_amdgcn_mfma_f32_32x32x16_bf16(pa2, PK(2), o[d0], 0, 0, 0);
        o[d0] = __builtin_amdgcn_mfma_f32_32x32x16_bf16(pa3, PK(3), o[d0], 0, 0, 0);
#undef PK
    }
}
template <int THRL> __device__ __forceinline__ void attn_unit(int b, int h, int qb, const bf16* Q, const bf16* __restrict__ K, const bf16* __restrict__ V, bf16* O, char* shm, const int wave_s) {
    int tid_ = wave_s * 64 + lane_id(); asm volatile("" : "+v"(tid_));
    const int tid = tid_, lane = tid & 63, r32 = lane & 31, hi = lane >> 5; const int wid = wave_s;
    const int q0 = qb * QB;
    const bf16* Qw = Q + ((long)b * SEQ_ + q0 + wid * QBLK) * DM + h * D;
    const bf16 *Kh = K + (long)b * LP * DM + h * D, *Vh = V + (long)b * LP * DM + h * D;
    const unsigned lds0 = (unsigned)(uintptr_t)shm;
    float* wsf = (float*)(shm + LDS_WS) + wid * 64;
    const bf16* ksrc = Kh + (long)lane * DM + wid * 8;
    const bf16* vsrc = Vh + (long)(16 * (wid & 3) + (lane >> 2)) * DM + (wid >> 2) * 32 + (lane & 3) * 8;
    const unsigned kdst = lds0 + LDS_K + wid * 1024, vdst = lds0 + LDS_V + wid * 1024;
#define DMA_K(t, slot) glds16(ksrc + (long)(t) * KVBLK * DM, (unsigned)__builtin_amdgcn_readfirstlane(kdst + (slot)))
#define DMA_V(t, slot) glds16(vsrc + (long)(t) * KVBLK * DM, (unsigned)__builtin_amdgcn_readfirstlane(vdst + (slot)))
    const int vb0 = (int)(lds0 + LDS_V) + ((lane >> 4) & 1) * 32 + (lane & 3) * 8 + (4 * hi + ((lane & 15) >> 2)) * 64;
    const char* Kbase = shm + LDS_K; bf16x8 kf[8];
    const lds_cptr shm3 = (lds_cptr)shm; const lds_cptr kp0 = shm3 + LDS_K + hi * 1024 + r32 * 16; const lds_cptr vp0 = shm3 + LDS_V + ((lane >> 4) & 1) * 32 + (lane & 3) * 8 + (4 * hi + ((lane & 15) >> 2)) * 64;
    const lds_fptr kbl = (lds_fptr)(shm3 + LDS_KB);
    const int NT = 4 * qb + 5;
    DMA_K(0, 0); DMA_V(0, 0); DMA_K(1, SLOTB);
    bf16x8 qr[4];
#pragma unroll
    for (int d0 = 0; d0 < 4; ++d0) qr[d0] = *reinterpret_cast<const bf16x8*>(&Qw[(long)r32 * DM + d0 * 16 + hi * 8]);
    const int qrel = wid * QBLK + r32;
    float nref = -kbl[64 + q0 + qrel];
    float l_reg = 0.f; f32x16 o[2]; o[0] = f32x16{}; o[1] = f32x16{};
#define CMASK(P0, P1, t) do { int jb_ = (t) - (NT - 4); if (jb_ >= 0) cmask(P0, P1, jb_, qrel, hi); } while (0)
    bool resc = false;
#define START(P0, P1) do { const float rm = rowmax(P0, P1); resc = false; \
    { const float dl = __builtin_fmaxf(rm, 0.f); nref = fsub_s(nref, dl); \
      _Pragma("unroll") for (int r = 0; r < 16; ++r) { P0[r] = fsub_s(P0[r], dl); P1[r] = fsub_s(P1[r], dl); } } \
    _Pragma("unroll") for (int r = 0; r < 16; ++r) P0[r] = __builtin_amdgcn_exp2f(P0[r]); } while (0)
#define RESC() do { if (resc) { asm volatile("s_waitcnt lgkmcnt(0)" ::: "memory"); \
      _Pragma("unroll") for (int d_ = 0; d_ < 2; ++d_) _Pragma("unroll") for (int r = 0; r < 16; ++r) o[d_][r] *= wsf[crow(r, hi)]; } } while (0)
    f32x16 pA0, pA1, pB0, pB1;
    int sl_prev = 0, sl_cur = 0, sl_next = SLOTB;
#define ROT() do { sl_prev = sl_cur; sl_cur = sl_next; sl_next = (sl_next == (NSLOT - 1) * SLOTB) ? 0 : sl_next + SLOTB; } while (0)
    DMA_K(2, 2 * SLOTB);
    WAIT_BAR(3);
    { f32x16 ci0, ci1; cinit(ci0, ci1, kbl, nref, hi);
      qkt(pB0, pB1, Kbase, qr, ci0, ci1, r32, hi); }
    asm volatile("s_nop 15\n\ts_nop 7" : "+v"(pB0), "+v"(pB1)); CMASK(pB0, pB1, 0);
    START(pB0, pB1);
    _Pragma("unroll") for (int r = 0; r < 16; ++r) pB1[r] = __builtin_amdgcn_exp2f(pB1[r]);
    WAIT_BAR(0);
    DMA_K(3, 0); DMA_V(1, SLOTB);
    ROT();
    kload8(kf, kp0 + sl_cur);
    WAIT_BAR(2);
    s16x4 vlo[8], vhi[8]; u32x4 pw0, pw1, pw2, pw3;
#define PKW(P, B) cvtpk_s(P[B], P[B + 1])
#define PAF(k) __builtin_bit_cast(bf16x8, pw##k)
#define VFR(i) (bf16x8){vlo[i][0], vlo[i][1], vlo[i][2], vlo[i][3], vhi[i][0], vhi[i][1], vhi[i][2], vhi[i][3]}
#define PIN(x) asm volatile("" : "+v"(x))
#define MX3(a, b, c) __builtin_fmaxf(__builtin_fmaxf((a), (b)), (c))
#define GAPA(MF, A0, A1, A2, A3, W0, W1, PW) do { MF; sacc += A0; sacc += A1; sacc += A2; sacc += A3; PIN(sacc); W0; W1; PIN(PW); SBAR(); } while (0)
#define EX(v) __builtin_amdgcn_exp2f(v)
#define GAPB(MF, X, B) do { MF; X[B] = EX(X[B]); X[B + 1] = EX(X[B + 1]); X[B + 2] = EX(X[B + 2]); X[B + 3] = EX(X[B + 3]); PIN(X); SBAR(); } while (0)
#define VRD(i) do { vlo[i] = vtr(vp_ + (((i) >> 2) * 4096 + ((i) & 3) * 1024)); vhi[i] = vtr(vp_ + (((i) >> 2) * 4096 + ((i) & 3) * 1024 + 512)); } while (0)
#define KRD(G, j) do { if (G) { kload2(kf, kp0 + sl_next, j); SBAR(); } } while (0)
#define STEP(C0, C1, P0, P1, t, GK, GV, GL) do { SBAR(); \
    const lds_cptr vp_ = vp0 + sl_prev; \
    f32x16 ci0_, ci1_; cinit(ci0_, ci1_, kbl + 64 * (t), nref, hi); SBAR(); \
    VRD(0); SBAR(); float sacc = (P0[0] + P0[1]); \
    GAPA(C0 = __builtin_amdgcn_mfma_f32_32x32x16_bf16(kf[0], qr[0], ci0_, 0, 0, 0), P0[2], P0[3], P0[4], P0[5],     pw0[0] = PKW(P0, 0), pw0[1] = PKW(P0, 2), pw0); \
    VRD(4); SBAR(); GAPA(C1 = __builtin_amdgcn_mfma_f32_32x32x16_bf16(kf[1], qr[0], ci1_, 0, 0, 0), P0[6], P0[7], P0[8], P0[9],     pw0[2] = PKW(P0, 4), pw0[3] = PKW(P0, 6), pw0); \
    VRD(1); SBAR(); GAPA(C0 = __builtin_amdgcn_mfma_f32_32x32x16_bf16(kf[2], qr[1], C0, 0, 0, 0),   P0[10], P0[11], P0[12], P0[13], pw1[0] = PKW(P0, 8), pw1[1] = PKW(P0, 10), pw1); \
    VRD(5); SBAR(); GAPA(C1 = __builtin_amdgcn_mfma_f32_32x32x16_bf16(kf[3], qr[1], C1, 0, 0, 0),   P0[14], P0[15], P1[0], P1[1],   pw1[2] = PKW(P0, 12), pw1[3] = PKW(P0, 14), pw1); \
    VRD(2); SBAR(); GAPA(C0 = __builtin_amdgcn_mfma_f32_32x32x16_bf16(kf[4], qr[2], C0, 0, 0, 0),   P1[2], P1[3], P1[4], P1[5],     pw2[0] = PKW(P1, 0), pw2[1] = PKW(P1, 2), pw2); \
    VRD(6); SBAR(); GAPA(C1 = __builtin_amdgcn_mfma_f32_32x32x16_bf16(kf[5], qr[2], C1, 0, 0, 0),   P1[6], P1[7], P1[8], P1[9],     pw2[2] = PKW(P1, 4), pw2[3] = PKW(P1, 6), pw2); \
    VRD(3); SBAR(); GAPA(C0 = __builtin_amdgcn_mfma_f32_32x32x16_bf16(kf[6], qr[3], C0, 0, 0, 0),   P1[10], P1[11], P1[12], P1[13], pw3[0] = PKW(P1, 8), pw3[1] = PKW(P1, 10), pw3); \
    VRD(7); SBAR(); GAPA(C1 = __builtin_amdgcn_mfma_f32_32x32x16_bf16(kf[7], qr[3], C1, 0, 0, 0),   P1[14], P1[15], 0.f, 0.f,       pw3[2] = PKW(P1, 12), pw3[3] = PKW(P1, 14), pw3); \
    l_reg += sacc; \
    if (GK) { DMA_K((t) + 3, sl_cur); } if (GV) { DMA_V((t) + 1, sl_next); } \
    CMASK(C0, C1, t); \
    { float a = MX3(C0[0], C0[1], C1[0]), b = MX3(C0[2], C0[3], C1[1]); a = MX3(a, C1[2], C1[3]); \
      _Pragma("unroll") for (int r = 4; r < 16; r += 4) { a = MX3(a, C0[r], C0[r + 1]); b = MX3(b, C0[r + 2], C0[r + 3]); a = MX3(a, C1[r], C1[r + 1]); b = MX3(b, C1[r + 2], C1[r + 3]); } \
      float rm = __builtin_fmaxf(a, b); { auto rr = __builtin_amdgcn_permlane32_swap(__float_as_uint(rm), __float_as_uint(rm), false, false); rm = __builtin_fmaxf(__uint_as_float(rr[0]), __uint_as_float(rr[1])); } \
      resc = false; \
      if (__builtin_expect(__any(rm > (float)THRL), 0)) { const float dl = __builtin_fmaxf(rm, 0.f); nref -= dl; \
        _Pragma("unroll") for (int r = 0; r < 16; ++r) { C0[r] -= dl; C1[r] -= dl; } \
        const float f = __builtin_amdgcn_exp2f(-dl); l_reg *= f; if (hi == 0) wsf[r32] = f; resc = true; } } \
    SBAR(); \
    GAPB(o[0] = __builtin_amdgcn_mfma_f32_32x32x16_bf16(PAF(0), VFR(0), o[0], 0, 0, 0), C0, 0); \
    GAPB(o[1] = __builtin_amdgcn_mfma_f32_32x32x16_bf16(PAF(0), VFR(4), o[1], 0, 0, 0), C0, 4); \
    KRD(GL, 0); GAPB(o[0] = __builtin_amdgcn_mfma_f32_32x32x16_bf16(PAF(1), VFR(1), o[0], 0, 0, 0), C0, 8); \
    KRD(GL, 1); GAPB(o[1] = __builtin_amdgcn_mfma_f32_32x32x16_bf16(PAF(1), VFR(5), o[1], 0, 0, 0), C0, 12); \
    KRD(GL, 2); GAPB(o[0] = __builtin_amdgcn_mfma_f32_32x32x16_bf16(PAF(2), VFR(2), o[0], 0, 0, 0), C1, 0); \
    KRD(GL, 3); GAPB(o[1] = __builtin_amdgcn_mfma_f32_32x32x16_bf16(PAF(2), VFR(6), o[1], 0, 0, 0), C1, 4); \
    GAPB(o[0] = __builtin_amdgcn_mfma_f32_32x32x16_bf16(PAF(3), VFR(3), o[0], 0, 0, 0), C1, 8); \
    GAPB(o[1] = __builtin_amdgcn_mfma_f32_32x32x16_bf16(PAF(3), VFR(7), o[1], 0, 0, 0), C1, 12); \
    } while (0)
#define ENDW(tt) do { if ((tt) + 3 < NT) { WAIT_BAR(2); } else if ((tt) + 2 < NT) { WAIT_BAR(1); } else { WAIT_BAR(0); } } while (0)
    STEP(pA0, pA1, pB0, pB1, 1, (1 + 3 < NT), (1 + 1 < NT), (1 + 1 < NT)); ENDW(1); RESC(); ROT();
    int t = 2;
#undef CMASK
#define CMASK(P0, P1, t) do { } while (0)
    for (; t + 5 < NT; t += 2) {
        STEP(pB0, pB1, pA0, pA1, t, true, true, true);       WAIT_BAR(2); RESC(); ROT();
        STEP(pA0, pA1, pB0, pB1, t + 1, true, true, true);   WAIT_BAR(2); RESC(); ROT();
    }
#undef CMASK
#define CMASK(P0, P1, t) do { int jb_ = (t) - (NT - 4); if (jb_ >= 0) cmask(P0, P1, jb_, qrel, hi); } while (0)
    for (; t + 1 < NT; t += 2) {
        STEP(pB0, pB1, pA0, pA1, t, (t + 3 < NT), (t + 1 < NT), (t + 1 < NT));         ENDW(t);     RESC(); ROT();
        STEP(pA0, pA1, pB0, pB1, t + 1, (t + 4 < NT), (t + 2 < NT), (t + 2 < NT));     ENDW(t + 1); RESC(); ROT();
    }
    STEP(pB0, pB1, pA0, pA1, NT - 1, false, false, false); RESC();
    { float sacc = pB0[0] + pB0[1]; _Pragma("unroll") for (int r = 2; r < 16; ++r) sacc += pB0[r]; _Pragma("unroll") for (int r = 0; r < 16; ++r) sacc += pB1[r]; l_reg += sacc;
      pw0 = (u32x4){PKW(pB0, 0), PKW(pB0, 2), PKW(pB0, 4), PKW(pB0, 6)}; pw1 = (u32x4){PKW(pB0, 8), PKW(pB0, 10), PKW(pB0, 12), PKW(pB0, 14)}; pw2 = (u32x4){PKW(pB1, 0), PKW(pB1, 2), PKW(pB1, 4), PKW(pB1, 6)}; pw3 = (u32x4){PKW(pB1, 8), PKW(pB1, 10), PKW(pB1, 12), PKW(pB1, 14)};
      SBAR(); pv(o, vb0 + sl_cur, PAF(0), PAF(1), PAF(2), PAF(3)); }
#undef PKW
#undef PAF
#undef VFR
#undef PIN
#undef MX3
#undef GAPA
#undef GAPB
#undef EX
#undef VRD
#undef KRD
#undef STEP
#undef ENDW
    { auto rr = __builtin_amdgcn_permlane32_swap(__float_as_uint(l_reg), __float_as_uint(l_reg), false, false); l_reg = __uint_as_float(rr[0]) + __uint_as_float(rr[1]); }
    if (hi == 0) wsf[32 + r32] = l_reg; asm volatile("s_waitcnt lgkmcnt(0)" ::: "memory");
    float rli[16];
#pragma unroll
    for (int r = 0; r < 16; ++r) rli[r] = __builtin_amdgcn_rcpf(wsf[32 + crow(r, hi)]);
    bf16* Ow = O + ((long)b * SEQ_ + q0 + wid * QBLK) * DM + h * D;
    { bf16* stg = (bf16*)(shm + LDS_OST) + wid * 2048;
#pragma unroll
      for (int r = 0; r < 16; ++r) { const int orow = crow(r, hi);
#pragma unroll
        for (int d0 = 0; d0 < 2; ++d0) stg[orow * 64 + d0 * 32 + r32] = __float2bfloat16(o[d0][r] * rli[r]); }
      asm volatile("s_waitcnt lgkmcnt(0)" ::: "memory");
#pragma unroll
      for (int i = 0; i < 4; ++i) { const int row = i * 8 + (lane >> 3), ch = lane & 7; const u32x4 v = *(const u32x4*)(stg + row * 64 + ch * 8); *(u32x4*)(Ow + (long)row * DM + ch * 8) = v; } }
    asm volatile("s_waitcnt lgkmcnt(0)\n\ts_barrier" ::: "memory");
#undef DMA_K
#undef DMA_V
#undef CMASK
#undef START
#undef RESC
#undef ROT
}
#undef SBAR
#undef WAIT_BAR
}

struct Args {
    const float *x, *meta, *g_mix, *w_in, *b_forget, *gq, *gk, *w_up_attn, *w_pool, *pool_scale, *w_up_pool, *w_out, *g_ffn, *w_group, *b_group, *w_router, *b_router, *w1, *w3, *w2;
    float* out; unsigned char* ws;
};

__device__ __forceinline__ unsigned f2bf(float f) { unsigned u = __builtin_bit_cast(unsigned, f); return (u + 0x7fffu + ((u >> 16) & 1u)) >> 16; }
__device__ __forceinline__ unsigned pk2(float lo, float hi) { return f2bf(lo) | (f2bf(hi) << 16); }

template <int MODE> __device__ __forceinline__ void p0_transpose_item(const float* W, int Kdim, int ldw, int nblk, const float* ks, bf16_t* WT, int row_off, LAS float* scr, int item, int lane) {
    const int kb = item / nblk, nb = item % nblk, k0 = 64 * kb, n0 = 32 * nb;
    const int sc0 = (MODE == 1) ? n0 + (n0 >= 1536 ? 8 : 0) : n0;
#pragma unroll 8
    for (int i = 0; i < 32; ++i) { const int kk = 2 * i + (lane >> 5); float v = W[(size_t)(k0 + kk) * ldw + sc0 + (lane & 31)]; if (ks) v *= ks[k0 + kk]; scr[kk * 33 + (lane & 31)] = v; }
    asm volatile("s_waitcnt lgkmcnt(0)" ::: "memory");
    const int c = lane & 7;
#pragma unroll
    for (int j = 0; j < 4; ++j) { const int nn = (lane >> 3) + 8 * j, n = n0 + nn; const LAS float* s = scr + (8 * c) * 33 + nn;
        u32x4 o; o.x = pk2(s[0 * 33], s[1 * 33]); o.y = pk2(s[2 * 33], s[3 * 33]); o.z = pk2(s[4 * 33], s[5 * 33]); o.w = pk2(s[6 * 33], s[7 * 33]);
        int dr;
        if (MODE == 0) dr = row_off + n;
        else if (MODE == 1) { const int L = n & 255; dr = (n & ~255) + 128 * ((L & 63) >> 5) + 32 * (L >> 6) + (L & 31); }
        else dr = row_off + 256 * (n >> 7) + (n & 127);
        *(u32x4*)(WT + (size_t)dr * Kdim + k0 + 8 * c) = o; }
    asm volatile("s_waitcnt lgkmcnt(0)" ::: "memory");
}

__device__ __forceinline__ void p0_row(const float* xrow, const float* gmix, bf16_t* orow, const LAS float* wf, const float* bf, int lane, float (&lf)[8]) {
    const f32x4* xr = (const f32x4*)xrow + lane; const f32x4* gr = (const f32x4*)gmix + lane;
    f32x4 v[4]; float s = 0.f;
#pragma unroll
    for (int j = 0; j < 4; ++j) { v[j] = xr[64 * j]; s += (v[j].x * v[j].x + v[j].y * v[j].y) + (v[j].z * v[j].z + v[j].w * v[j].w); }
    const float rstd = 1.0f / sqrtf(wave_sum(s) * (1.f / DM_) + RMS_EPS);
#pragma unroll
    for (int j = 0; j < 4; ++j) v[j] = v[j] * rstd * gr[64 * j];
    unsigned long long* o8 = (unsigned long long*)orow + lane;
#pragma unroll
    for (int j = 0; j < 4; ++j) o8[64 * j] = (unsigned long long)pk2(v[j].x, v[j].y) | ((unsigned long long)pk2(v[j].z, v[j].w) << 32);
#pragma unroll
    for (int h = 0; h < 8; ++h) { float z = 0.f;
#pragma unroll
        for (int j = 0; j < 4; ++j) { const f32x4 w = *(const LAS f32x4*)(wf + h * 1024 + 256 * j + 4 * lane); z += (v[j].x * w.x + v[j].y * w.y) + (v[j].z * w.z + v[j].w * w.w); }
        z = wave_sum(z) + bf[h];
        lf[h] = fminf(z, 0.f) - log1pf(expf(-fabsf(z))); }
}

__global__ void __launch_bounds__(512, 2) fwd_megakernel(Args args) {
    extern __shared__ __attribute__((aligned(16))) unsigned char lds[];
    cg::grid_group grid = cg::this_grid();
    LAS unsigned char* L = (LAS unsigned char*)lds;
    const int wave = __builtin_amdgcn_readfirstlane(threadIdx.x >> 6);
#define tid (wave * 64 + lane_id())
#define lane lane_id()
    const int G = gridDim.x, bx = blockIdx.x, vcu = (G % 8 == 0) ? (bx % 8) * (G / 8) + bx / 8 : bx;
    unsigned char* ws = args.ws;
    unsigned* ctl = (unsigned*)(ws + WS_CTL);
    bf16_t* Wmain = (bf16_t*)(ws + WS_WMAIN); bf16_t* Wa = (bf16_t*)(ws + WS_WA); bf16_t* We = (bf16_t*)(ws + WS_WE); bf16_t* Wout = (bf16_t*)(ws + WS_WOUT);
    bf16_t* Wr = (bf16_t*)(ws + WS_WR); bf16_t* HNM = (bf16_t*)(ws + WS_HNM); float* LF = (float*)(ws + WS_LF); float* SSQ = (float*)(ws + WS_SSQ);
    bf16_t* W13 = (bf16_t*)(ws + WS_W13); bf16_t* W2t = (bf16_t*)(ws + WS_W2);
    int* TOK = (int*)(ws + WS_TOK); float* RS = (float*)(ws + WS_RS); float* CWt = (float*)(ws + WS_CW);
    bf16_t* HN = (bf16_t*)(ws + WS_RA); bf16_t* YP = HN; bf16_t* H1B = HN;
    bf16_t* Gt = (bf16_t*)(ws + WS_RB); bf16_t* HH = Gt;
    bf16_t* Qb = (bf16_t*)(ws + WS_Q); bf16_t* Kb = (bf16_t*)(ws + WS_K); bf16_t* Vb = (bf16_t*)(ws + WS_V); bf16_t* Ub = (bf16_t*)(ws + WS_U);
    bf16_t* MG = (bf16_t*)(ws + WS_MG); bf16_t* Ob = (bf16_t*)(ws + WS_O); bf16_t* MIX = (bf16_t*)(ws + WS_MIX);
    const int gw = vcu * 8 + wave, NGW = G * 8;

    if (PH(0)) {
        LAS float* wf = (LAS float*)L;
        for (int i = tid; i < 8 * 1024; i += 512) { const int h = i >> 10, k = i & 1023; wf[i] = args.w_in[(size_t)k * 4104 + 1536 + h]; }
        __syncthreads();
        for (int m = gw; m < MX + NMETA; m += NGW) {
            float lf[8];
            if (m < MX) { p0_row(args.x + (size_t)m * DM_, args.g_mix, HN + (size_t)m * DM_, wf, args.b_forget, lane, lf);
                if (lane < 8) { float v = lf[0];
#pragma unroll
                    for (int h = 1; h < 8; ++h) v = (lane == h) ? lf[h] : v;
                    const int b = m >> 12, t = m & 4095; LF[(size_t)(b * 8 + lane) * LP + 64 + t] = v; } }
            else { const int i = m - MX; p0_row(args.meta + (size_t)i * DM_, args.g_mix, HNM + (size_t)i * DM_, wf, args.b_forget, lane, lf);
                float v = lf[0];
#pragma unroll
                for (int h = 1; h < 8; ++h) v = ((lane & 7) == h) ? lf[h] : v;
                LF[(size_t)lane * LP + 48 + i] = v; }
        }
        for (int i = bx * 512 + tid; i < 64 * 48; i += G * 512) LF[(size_t)(i / 48) * LP + (i % 48)] = 0.f;
        for (int i = bx * 512 + tid; i < NBATCH * 48 * 64; i += G * 512) { const int b = i / (48 * 64), r = (i / 64) % 48, c = (i % 64) * 8; const size_t off = ((size_t)(b * LP + r)) * 512 + c; const u32x4 z = {0u, 0u, 0u, 0u};
            *(u32x4*)(Kb + off) = z; *(u32x4*)(Vb + off) = z; *(u32x4*)(Ub + off) = z; }
        for (int i = bx * 512 + tid; i < 48 * 1024; i += G * 512) { const int j = i >> 10, k = i & 1023; float v = 0.f;
            if (j < 4) v = args.w_group[k * 4 + j] * args.g_ffn[k]; else if (j < 36) v = args.w_router[k * 32 + (j - 4)] * args.g_ffn[k];
            Wr[i] = (bf16_t)f2bf(v); }
        __syncthreads();
        LAS float* scr = (LAS float*)(L + wave * 16384);
        constexpr int I_MAIN = 16 * 128, I_WA = 8 * 32, I_WOUT = 16 * 32, I_W1 = NEXP * 16 * 8, I_W2 = NEXP * 4 * 32, I_WE = 4 * 32 * 16;
        constexpr int NITEMS = I_MAIN + I_WA + I_WOUT + 2 * I_W1 + I_W2 + I_WE;
        for (int it = gw; it < NITEMS; it += NGW) {
            int r = it;
            if (r < I_MAIN) { p0_transpose_item<1>(args.w_in, 1024, 4104, 128, nullptr, Wmain, 0, scr, r, lane); continue; } r -= I_MAIN;
            if (r < I_WA) { p0_transpose_item<0>(args.w_up_attn, 512, 1024, 32, nullptr, Wa, 0, scr, r, lane); continue; } r -= I_WA;
            if (r < I_WOUT) { p0_transpose_item<0>(args.w_out, 1024, 1024, 32, nullptr, Wout, 0, scr, r, lane); continue; } r -= I_WOUT;
            if (r < I_W1) { const int e = r / 128; p0_transpose_item<2>(args.w1 + (size_t)e * 1024 * 256, 1024, 256, 8, args.g_ffn, W13, e * 512, scr, r % 128, lane); continue; } r -= I_W1;
            if (r < I_W1) { const int e = r / 128; p0_transpose_item<2>(args.w3 + (size_t)e * 1024 * 256, 1024, 256, 8, args.g_ffn, W13, e * 512 + 128, scr, r % 128, lane); continue; } r -= I_W1;
            if (r < I_W2) { const int e = r / 128; p0_transpose_item<0>(args.w2 + (size_t)e * 256 * 1024, 256, 1024, 32, nullptr, W2t, e * 1024, scr, r % 128, lane); continue; } r -= I_W2;
            {
                const int g = r / 512, cq = (r / 16) % 32, nb = r % 16, n = nb * 64 + lane;
                float a0 = 0.f, a1 = 0.f, a2 = 0.f, a3 = 0.f;
                const float* wp = args.w_pool + ((size_t)g * 128 + cq * 4) * 128;
                for (int d = 0; d < 128; ++d) { const float wu = args.w_up_pool[(size_t)(g * 128 + d) * 1024 + n] * args.pool_scale[g * 128 + d];
                    a0 += wp[d] * wu; a1 += wp[128 + d] * wu; a2 += wp[256 + d] * wu; a3 += wp[384 + d] * wu; }
                u32x2 o; o.x = pk2(a0, a1); o.y = pk2(a2, a3);
                *(u32x2*)(We + (size_t)n * 512 + g * 128 + cq * 4) = o;
            }
        }
    }
    grid.sync();

    if (PH(1)) {
        if (bx < 3) {
            const int item = bx * 8 + wave, typ = item >> 3, hh = item & 7, pn = 2 + 2 * typ + (hh >> 2), wcc = hh & 3;
            f32x4 c4[4] = {{0.f, 0.f, 0.f, 0.f}, {0.f, 0.f, 0.f, 0.f}, {0.f, 0.f, 0.f, 0.f}, {0.f, 0.f, 0.f, 0.f}};
            const int r16 = lane & 15, q4 = lane >> 4;
            for (int kk = 0; kk < 32; ++kk) {
                const bf16x8 a = *(const bf16x8*)(HNM + (size_t)r16 * 1024 + kk * 32 + 8 * q4);
#pragma unroll
                for (int ct = 0; ct < 4; ++ct) { const int d = ct * 16 + r16;
                    const bf16x8 bb = *(const bf16x8*)(Wmain + (size_t)(256 * pn + 128 * (d >> 5) + 32 * wcc + (d & 31)) * 1024 + kk * 32 + 8 * q4);
                    c4[ct] = __builtin_amdgcn_mfma_f32_16x16x32_bf16(a, bb, c4[ct], 0, 0, 0); }
            }
#pragma unroll
            for (int reg = 0; reg < 4; ++reg) {
                float v[4]; float ss = 0.f;
#pragma unroll
                for (int ct = 0; ct < 4; ++ct) { v[ct] = c4[ct][reg]; ss += v[ct] * v[ct]; }
                ss += __shfl_xor(ss, 1); ss += __shfl_xor(ss, 2); ss += __shfl_xor(ss, 4); ss += __shfl_xor(ss, 8);
                const float rn = (typ == 0) ? __builtin_amdgcn_rsqf(ss * (1.f / 64.f) + RMS_EPS) : 1.f;
                bf16_t* dst = (typ == 0 ? Kb : (typ == 1 ? Vb : Ub));
                const int mi = 4 * q4 + reg;
#pragma unroll
                for (int ct = 0; ct < 4; ++ct) { const int d = ct * 16 + r16; const float o = (typ == 0) ? v[ct] * rn * args.gk[d] : v[ct]; const bf16_t ob = (bf16_t)f2bf(o);
#pragma unroll
                    for (int b = 0; b < NBATCH; ++b) dst[((size_t)(b * LP + 48 + mi)) * 512 + 64 * hh + d] = ob; }
            }
        }
        pg8::GridOrder S; S.init(HN, Wmain, MX, NMAIN, 1024, G, bx);
        EpiInProj E{Qb, Kb, Vb, Ub, Gt, args.gq, args.gk};
        pg8::gemm_phase<EpiInProj, pg8::GridOrder, false>(L, 1024, S, E, wave);
    }
    grid.sync();

    if (DBG_STOP == 1) {
        for (size_t i = (size_t)bx * 512 + tid; i < (size_t)MX * 1024; i += (size_t)G * 512) { const int m = (int)(i >> 10), c = (int)(i & 1023), c5 = c & 511; const size_t pr = (size_t)m + 64 * ((m >> 12) + 1);
            float v = bf_lo(Qb[(size_t)m * 512 + c5]) + 3.f * bf_lo(Kb[pr * 512 + c5]) + 5.f * bf_lo(Vb[pr * 512 + c5]) + 7.f * bf_lo(Ub[pr * 512 + c5]); (void)Gt;
            args.out[i] = v; }
        return; }
    if (PH(2)) {
        for (int idx = bx * 512 + tid; idx < MX * 64; idx += G * 512) {
            const int m = idx >> 6, ch = idx & 63, w = 2 << (ch >> 4);
            const size_t prow = (size_t)m + 64 * ((m >> 12) + 1);
            const bf16_t* up = Ub + prow * 512 + ch * 8;
            float s[8] = {0.f, 0.f, 0.f, 0.f, 0.f, 0.f, 0.f, 0.f}; float c0[8];
            for (int j = 0; j < w; ++j) { const u32x4 v = *(const u32x4*)(up - (size_t)j * 512);
                const float f[8] = {bf_lo(v.x), bf_hi(v.x), bf_lo(v.y), bf_hi(v.y), bf_lo(v.z), bf_hi(v.z), bf_lo(v.w), bf_hi(v.w)};
#pragma unroll
                for (int i = 0; i < 8; ++i) { s[i] += f[i]; if (j == 0) c0[i] = f[i]; } }
            const float inv = 1.0f / (float)w;
            u32x4 o; o.x = pk2(s[0] * inv - c0[0], s[1] * inv - c0[1]); o.y = pk2(s[2] * inv - c0[2], s[3] * inv - c0[3]); o.z = pk2(s[4] * inv - c0[4], s[5] * inv - c0[5]); o.w = pk2(s[6] * inv - c0[6], s[7] * inv - c0[7]);
            *(u32x4*)(MIX + (size_t)m * 512 + ch * 8) = o;
        }
        const int bh = vcu >> 2, u4 = vcu & 3;
        LAS float* kb = (LAS float*)(L + attn_body::LDS_KB);
        LAS float* part = (LAS float*)(L + attn_body::LDS_WS);
        {
            const float* lf = LF + (size_t)bh * LP; float v[9]; float run = 0.f;
#pragma unroll
            for (int i = 0; i < 9; ++i) { const int p = tid * 9 + i; v[i] = (p < LP) ? lf[p] : 0.f; run += v[i]; v[i] = run; }
            float inc = run;
#pragma unroll
            for (int o = 1; o < 64; o <<= 1) { const float y = __shfl_up(inc, o); if (lane >= o) inc += y; }
            if (lane == 63) part[wave] = inc;
            __syncthreads();
            float base = inc - run;
            for (int w = 0; w < wave; ++w) base += part[w];
#pragma unroll
            for (int i = 0; i < 9; ++i) { const int p = tid * 9 + i; if (p < LP) kb[p] = (p < 48) ? -INFINITY : -(base + v[i]) * LOG2E; }
            __syncthreads();
        }
        if (vcu < 256) {
            const int b = bh >> 3, h = bh & 7;
            const int qbs[4] = {15 - u4, 11 - u4, 4 + u4, u4};
#pragma unroll 1
            for (int i = 0; i < 4; ++i) attn_body::attn_unit<8>(b, h, qbs[i], (const attn_body::bf16*)Qb, (const attn_body::bf16*)Kb, (const attn_body::bf16*)Vb, (attn_body::bf16*)Ob, (char*)lds, wave);
        }
    }
    grid.sync();

    if (DBG_STOP == 2) {
        for (size_t i = (size_t)bx * 512 + tid; i < (size_t)MX * 1024; i += (size_t)G * 512) { const int m = (int)(i >> 10), c = (int)(i & 1023);
            args.out[i] = (c < 512) ? bf_lo(Ob[(size_t)m * 512 + c]) : bf_lo(MIX[(size_t)m * 512 + c - 512]); }
        return; }
    if (PH(3)) {
        { pg8::GridOrder S; S.init(MIX, We, MX, 1024, 512, G, bx); EpiGate<false> E{YP, Gt + 1024, nullptr}; pg8::gemm_phase<EpiGate<false>, pg8::GridOrder, false>(L, 512, S, E, wave); }
        { pg8::GridOrder S; S.init(Ob, Wa, MX, 1024, 512, G, bx); EpiGate<true> E{MG, Gt, YP}; pg8::gemm_phase<EpiGate<true>, pg8::GridOrder, false>(L, 512, S, E, wave); }
    }
    grid.sync();

    if (DBG_STOP == 3) {
        for (size_t i = (size_t)bx * 512 + tid; i < (size_t)MX * 1024; i += (size_t)G * 512) args.out[i] = bf_lo(MG[i]);
        return; }
    if (PH(4)) {
        pg8::GridOrder S; S.init(MG, Wout, MX, 1024, 1024, G, bx); EpiResid E{args.x, args.out, H1B, SSQ};
        pg8::gemm_phase<EpiResid, pg8::GridOrder, false>(L, 1024, S, E, wave);
    }
    grid.sync();

    if (DBG_STOP == 4) return;
    if (PH(5)) {
        constexpr int WRP = 2064;
        LAS unsigned char* WrL = L;
        LAS float* Lg = (LAS float*)(L + 100 * 1024) + wave * (16 * 48);
        LAS int* hist = (LAS int*)(L + LDSX_OFF);
        for (int i = tid; i < 48 * 128; i += 512) { const int r = i >> 7, c = i & 127; *(LAS u32x4*)(WrL + r * WRP + c * 16) = *(const u32x4*)(Wr + (size_t)r * 1024 + c * 8); }
        if (tid < 128) hist[tid] = 0;
        __syncthreads();
        int my_m = -1, l1 = 0, l2 = 0, r1 = 0, r2 = 0; float w1v = 0.f, w2v = 0.f, rstd = 0.f;
        for (int rb = bx; rb < MX / 128; rb += G) {
            const int m0 = rb * 128 + wave * 16, r16 = lane & 15, q4 = lane >> 4;
            f32x4 c3[3] = {{0.f, 0.f, 0.f, 0.f}, {0.f, 0.f, 0.f, 0.f}, {0.f, 0.f, 0.f, 0.f}};
            for (int kk = 0; kk < 32; ++kk) {
                const bf16x8 a = *(const bf16x8*)(H1B + (size_t)(m0 + r16) * 1024 + kk * 32 + 8 * q4);
#pragma unroll
                for (int nt3 = 0; nt3 < 3; ++nt3) { const bf16x8 bb = *(const LAS bf16x8*)(WrL + (nt3 * 16 + r16) * WRP + (kk * 32 + 8 * q4) * 2);
                    c3[nt3] = __builtin_amdgcn_mfma_f32_16x16x32_bf16(a, bb, c3[nt3], 0, 0, 0); }
            }
#pragma unroll
            for (int nt3 = 0; nt3 < 3; ++nt3)
#pragma unroll
                for (int reg = 0; reg < 4; ++reg) Lg[(4 * q4 + reg) * 48 + nt3 * 16 + r16] = c3[nt3][reg];
            asm volatile("s_waitcnt lgkmcnt(0)" ::: "memory");
            if (lane < 16) {
                const int m = m0 + lane; float ss = 0.f;
#pragma unroll
                for (int p = 0; p < 16; ++p) ss += SSQ[(size_t)m * 16 + p];
                rstd = 1.0f / sqrtf(ss * (1.f / DM_) + RMS_EPS);
                const LAS float* lg = Lg + lane * 48;
                float gl[4]; int gi = 0; float gm = -INFINITY;
#pragma unroll
                for (int j = 0; j < 4; ++j) { gl[j] = lg[j] * rstd + args.b_group[j]; if (gl[j] > gm) { gm = gl[j]; gi = j; } }
                float gden = 0.f;
#pragma unroll
                for (int j = 0; j < 4; ++j) gden += expf(gl[j] - gm);
                const float gtop = 1.0f / gden;
                float el[8]; int e1 = 0; float m1 = -INFINITY;
#pragma unroll
                for (int j = 0; j < 8; ++j) { el[j] = lg[4 + gi * 8 + j] * rstd + args.b_router[gi * 8 + j]; if (el[j] > m1) { m1 = el[j]; e1 = j; } }
                int e2 = 0; float m2 = -INFINITY;
#pragma unroll
                for (int j = 0; j < 8; ++j) if (j != e1 && el[j] > m2) { m2 = el[j]; e2 = j; }
                const float q2 = expf(m2 - m1), inv = gtop / (1.0f + q2);
                w1v = inv; w2v = q2 * inv;
                l1 = gi * 8 + e1; l2 = 32 + gi * 8 + e2; my_m = m;
                r1 = __hip_atomic_fetch_add(hist + l1, 1, __ATOMIC_RELAXED, __HIP_MEMORY_SCOPE_WORKGROUP);
                r2 = __hip_atomic_fetch_add(hist + l2, 1, __ATOMIC_RELAXED, __HIP_MEMORY_SCOPE_WORKGROUP);
            }
            __syncthreads();
            if (tid < 64) { const int n = hist[tid]; hist[64 + tid] = n ? (int)__hip_atomic_fetch_add(ctl + CW_CNT + tid, (unsigned)n, __ATOMIC_RELAXED, __HIP_MEMORY_SCOPE_AGENT) : 0; }
            __syncthreads();
            if (lane < 16 && my_m >= 0) {
                const int p1 = l1 * LCAP + hist[64 + l1] + r1, p2 = l2 * LCAP + hist[64 + l2] + r2;
                TOK[p1] = my_m; RS[p1] = rstd; CWt[p1] = w1v; TOK[p2] = my_m; RS[p2] = rstd; CWt[p2] = w2v;
            }
            __syncthreads();
            if (tid < 64) hist[tid] = 0;
            __syncthreads();
        }
    }
    grid.sync();

    if (PH(6)) {
        LAS int* pre = (LAS int*)(L + LDSX_OFF + 1024);
        LAS int* cntl = (LAS int*)(L + LDSX_OFF + 2048);
        if (tid == 0) { int run = 0; for (int l = 0; l < 64; ++l) { const int c = (int)__hip_atomic_load(ctl + CW_CNT + l, __ATOMIC_RELAXED, __HIP_MEMORY_SCOPE_AGENT); cntl[l] = c; pre[l] = run; run += (c + 255) >> 8; } pre[64] = run; }
        __syncthreads();
        if (PH(7)) { MoeOrder<2, true> S{pre, cntl, 0, 64, G, bx, (const char*)H1B, (const char*)W13, TOK}; EpiSwiGLU E{HH, RS, CWt};
          pg8::gemm_phase<EpiSwiGLU, MoeOrder<2, true>, true>(L, 1024, S, E, wave); }
        grid.sync();
        if (PH(8)) { MoeOrder<4, false> S{pre, cntl, 0, 32, G, bx, (const char*)HH, (const char*)W2t, TOK}; EpiScatter E{args.out, TOK};
          pg8::gemm_phase<EpiScatter, MoeOrder<4, false>, false>(L, 256, S, E, wave); }
        grid.sync();
        if (PH(9)) { MoeOrder<4, false> S{pre, cntl, 32, 32, G, bx, (const char*)HH, (const char*)W2t, TOK}; EpiScatter E{args.out, TOK};
          pg8::gemm_phase<EpiScatter, MoeOrder<4, false>, false>(L, 256, S, E, wave); }
    }
#undef tid
#undef lane
}

extern "C" void kernel_launch(void* const* d_in, const int* in_sizes, int n_in, void* d_out, int out_size, void* d_ws, size_t ws_size, hipStream_t stream) {
    static int grid = 0;
    if (grid == 0) {
        if (n_in != 20 || in_sizes[0] != MX * DM_ || out_size != MX * DM_ || ws_size < WS_END) { fprintf(stderr, "kernel_launch: unexpected shapes (n_in %d, in0 %d, out %d, ws %zu)\n", n_in, n_in > 0 ? in_sizes[0] : -1, out_size, ws_size); grid = -1; return; }
        int dev = 0, cus = 0, per_cu = 0;
        if (hipGetDevice(&dev) != hipSuccess || hipDeviceGetAttribute(&cus, hipDeviceAttributeMultiprocessorCount, dev) != hipSuccess) { grid = -1; return; }
        if (hipFuncSetAttribute((const void*)fwd_megakernel, hipFuncAttributeMaxDynamicSharedMemorySize, LDS_BYTES) != hipSuccess) { fprintf(stderr, "kernel_launch: hipFuncSetAttribute failed\n"); grid = -1; return; }
        if (hipOccupancyMaxActiveBlocksPerMultiprocessor(&per_cu, (const void*)fwd_megakernel, 512, LDS_BYTES) != hipSuccess || per_cu < 1) { fprintf(stderr, "kernel_launch: occupancy query says %d\n", per_cu); (void)hipGetLastError(); grid = -1; return; }
        grid = cus;
        if (grid != 256) fprintf(stderr, "kernel_launch: %d CUs (built for 256)\n", grid);
    }
    if (grid < 0) return;
    (void)hipMemsetAsync((char*)d_ws + WS_CTL, 0, CTL_BYTES, stream);
    Args a{};
    a.x = (const float*)d_in[0]; a.meta = (const float*)d_in[1]; a.g_mix = (const float*)d_in[2]; a.w_in = (const float*)d_in[3]; a.b_forget = (const float*)d_in[4];
    a.gq = (const float*)d_in[5]; a.gk = (const float*)d_in[6]; a.w_up_attn = (const float*)d_in[7]; a.w_pool = (const float*)d_in[8]; a.pool_scale = (const float*)d_in[9];
    a.w_up_pool = (const float*)d_in[10]; a.w_out = (const float*)d_in[11]; a.g_ffn = (const float*)d_in[12]; a.w_group = (const float*)d_in[13]; a.b_group = (const float*)d_in[14];
    a.w_router = (const float*)d_in[15]; a.b_router = (const float*)d_in[16]; a.w1 = (const float*)d_in[17]; a.w3 = (const float*)d_in[18]; a.w2 = (const float*)d_in[19];
    a.out = (float*)d_out; a.ws = (unsigned char*)d_ws;
    void* kargs[] = {&a};
    hipError_t e = hipLaunchCooperativeKernel((void*)fwd_megakernel, dim3(grid), dim3(512), kargs, LDS_BYTES, stream);
    if (e != hipSuccess) fprintf(stderr, "cooperative launch failed: %s (grid %d)\n", hipGetErrorString(e), grid);
}
```

```cpp
#include <hip/hip_runtime.h>
#include <hip/hip_cooperative_groups.h>
#include <hip/hip_bf16.h>
#include <cstdio>
#include <cstdint>
#include <cmath>
namespace cg = cooperative_groups;

constexpr int DM_ = 1024, NBATCH = 8, SEQ_ = 4096, MX = NBATCH * SEQ_;
constexpr int NMETA = 16, LP = 4160, KVR = NBATCH * LP;
constexpr int NHEAD_ = 8, HD_ = 64, AW = 512, PW = 512, NMAIN = 4096;
constexpr int NEXP = 32, FH = 256, LCAP = 32768;
constexpr float RMS_EPS = 1e-6f;
constexpr float LOG2E = 1.4426950408889634f;
constexpr float C2 = 0.125f * LOG2E;

constexpr size_t MiB = 1u << 20;
constexpr size_t WS_CTL = 0, CTL_BYTES = 65536;
constexpr size_t WS_WMAIN = 2 * MiB, WS_WA = 10 * MiB, WS_WE = 11 * MiB, WS_WOUT = 12 * MiB, WS_WR = 14 * MiB, WS_HNM = 15 * MiB;
constexpr size_t WS_RINV = 15 * MiB + 512 * 1024;
constexpr size_t WS_LF = 16 * MiB, WS_SSQ = 18 * MiB, WS_W13 = 20 * MiB, WS_W2 = 52 * MiB;
constexpr size_t WS_TOK = 68 * MiB, WS_RS = 76 * MiB, WS_CW = 84 * MiB;
constexpr size_t WS_RA = 96 * MiB;
constexpr size_t WS_RB = 160 * MiB;
constexpr size_t WS_Q = 288 * MiB, WS_K = 320 * MiB, WS_V = 353 * MiB, WS_U = 386 * MiB;
constexpr size_t WS_MG = 288 * MiB;
constexpr size_t WS_HN8 = 224 * MiB;
constexpr size_t WS_H1B8 = 353 * MiB;
constexpr size_t WS_WG8 = 6 * MiB;
constexpr size_t WS_O = 420 * MiB, WS_MIX = 452 * MiB, WS_END = 484 * MiB;
constexpr int CW_CNT = 0, CW_XBAR = 4096;

#ifndef PH_MASK
#define PH_MASK 0xffff
#endif
#define PH(k) ((PH_MASK >> (k)) & 1)
#ifndef PROBE_PHASE
#define PROBE_PHASE -1
#endif
constexpr int RING_BYTES = 131072, LDSX_OFF = RING_BYTES, LDS_BYTES = 147456;

#define LAS __attribute__((address_space(3)))
typedef unsigned short bf16_t;
typedef short bf16x8 __attribute__((ext_vector_type(8)));
typedef float f32x4 __attribute__((ext_vector_type(4)));
typedef float f32x2 __attribute__((ext_vector_type(2)));
typedef unsigned u32x4 __attribute__((ext_vector_type(4)));
typedef unsigned u32x2 __attribute__((ext_vector_type(2)));

typedef __bf16 bf16x2_v __attribute__((ext_vector_type(2)));
__device__ __forceinline__ unsigned cvt_pk_bf16(float lo, float hi) { f32x2 v = {lo, hi}; bf16x2_v b = __builtin_convertvector(v, bf16x2_v); return __builtin_bit_cast(unsigned, b); }
__device__ __forceinline__ float bf_lo(unsigned w) { return __uint_as_float(w << 16); }
__device__ __forceinline__ float bf_hi(unsigned w) { return __uint_as_float(w & 0xffff0000u); }
__device__ __forceinline__ float fast_sigmoid(float x) { return __builtin_amdgcn_rcpf(1.0f + __builtin_amdgcn_exp2f(-x * LOG2E)); }
__device__ __forceinline__ int lane_id() { unsigned z = 0u; asm volatile("" : "+v"(z)); return (int)__builtin_amdgcn_mbcnt_hi(~0u, __builtin_amdgcn_mbcnt_lo(~0u, z)); }
__device__ __forceinline__ float wave_sum(float v) {
#pragma unroll
    for (int o = 1; o < 64; o <<= 1) v += __shfl_xor(v, o);
    return v;
}

namespace pg8 {
constexpr int BM = 256, BK = 64, HALF = 128, HTB = HALF * BK * 2, NXCD = 8, WGM = 4;
__host__ __device__ __forceinline__ int lds_byte(int r, int c) { const int st = (r >> 4) * 2 + (c >> 5), rr = r & 15, cc = c & 31, ob = rr * 64 + cc * 2; return st * 1024 + (ob ^ (((ob >> 9) & 1) << 5)); }
__host__ __device__ __forceinline__ void stage_rc(int b, int& R, int& C) { const int st = b / 1024, sb = b % 1024, swz = sb ^ (((sb >> 9) & 1) << 5); R = (st >> 1) * 16 + swz / 64; C = (st & 1) * 32 + (swz % 64) / 2; }
__host__ __device__ __forceinline__ int perm32(int rho) { const int n = rho >> 4, i = rho & 15; return 8 * (i >> 2) + 4 * n + (i & 3); }

struct Unit { const char* a; const char* b; const int* tok; int pm, pn, cnt, aux, hrow; };

struct GridOrder {
    int nM, nN, nwg, G, c; const char* A; const char* B; size_t tsA, tsB;
    __device__ void init(const void* A_, const void* B_, int M, int N, int K, int G_, int c_) { nM = M / BM; nN = N / BM; nwg = nM * nN; G = G_; c = c_; A = (const char*)A_; B = (const char*)B_; tsA = (size_t)BM * K * 2; tsB = tsA; }
    __device__ bool next(int i, Unit& u) const {
        const long L = (long)i * G + c; if (L >= nwg) return false;
        int wgid = (int)L; { const int q = nwg / NXCD, r = nwg % NXCD, xcd = wgid % NXCD, off = wgid / NXCD; wgid = (xcd < r ? xcd * (q + 1) : r * (q + 1) + (xcd - r) * q) + off; }
        const int nig = WGM * nN, gid = wgid / nig, fm = gid * WGM, gsz = (nM - fm) < WGM ? (nM - fm) : WGM;
        u.pm = fm + ((wgid % nig) % gsz); u.pn = (wgid % nig) / gsz; u.a = A + (size_t)u.pm * tsA; u.b = B + (size_t)u.pn * tsB; u.tok = nullptr; u.cnt = 256; u.aux = 0; u.hrow = 0; return true;
    }
};

typedef int pg8_v4i __attribute__((ext_vector_type(4)));
typedef int pg8_v8i __attribute__((ext_vector_type(8)));
__device__ __forceinline__ pg8_v8i pg8_cat(bf16x8 lo, bf16x8 hi) { const pg8_v4i a = __builtin_bit_cast(pg8_v4i, lo), b = __builtin_bit_cast(pg8_v4i, hi); return __builtin_shufflevector(a, b, 0, 1, 2, 3, 4, 5, 6, 7); }
template <class Epi, class Sched, bool GATHER, bool HOOK = false, bool TPROBE = false, bool FP8 = false>
__device__ __forceinline__ void gemm_phase(LAS unsigned char* lds, const int K, const Sched& S, const Epi& E, const int wave_s) {
    int tid_ = wave_s * 64 + lane_id(); asm volatile("" : "+v"(tid_));
    const int tid = tid_, wid = wave_s, lane = tid & 63, wr = wid >> 2, wc = wid & 3, fr = lane & 15, fq = lane >> 4;
    const int nt = K / BK;
    int Rr[2], Cc[2]; unsigned voffB[2];
#pragma unroll
    for (int i = 0; i < 2; ++i) { stage_rc(tid * 16 + i * 8192, Rr[i], Cc[i]); const int Rb = (Rr[i] & ~31) + perm32(Rr[i] & 31); voffB[i] = (unsigned)(Rb * K + Cc[i]) * 2u; }
    const size_t kstep = (size_t)(BK * 2);
    const size_t hstep = (size_t)HALF * K * 2;
    const unsigned ldsw = (unsigned)wid * 1024u;
    const int aoff = lds_byte(wr * 64 + fr, fq * 8), boff = lds_byte(wc * 32 + fr, fq * 8);
#define PG8_SA(b, h) (((b) * 2 + (h)) * HTB)
#define PG8_SB(b, h) ((4 + (b) * 2 + (h)) * HTB)
#define PG8_STAGE(bufoff, gbase, voff) do { _Pragma("unroll") for (int _i = 0; _i < 2; ++_i) \
        __builtin_amdgcn_global_load_lds((const unsigned*)((const char*)(gbase) + (voff)[_i]), (LAS unsigned*)(lds + (bufoff) + ldsw + _i * 8192), 16, 0, 0); } while (0)
#define PG8_LD8(dstv, off) do { const pg8_v4i _lo = *(const LAS pg8_v4i*)(lds + (off)), _hi = *(const LAS pg8_v4i*)(lds + (off) + 1024); dstv = __builtin_shufflevector(_lo, _hi, 0, 1, 2, 3, 4, 5, 6, 7); } while (0)
#define PG8_LDA(dst, b, h) do { if constexpr (FP8) { _Pragma("unroll") for (int m = 0; m < 4; ++m) PG8_LD8(At8[m], PG8_SA(b, h) + aoff + m * 2048); } else PG8_LDA_(dst, b, h); } while (0)
#define PG8_LDB(dst, b, h) do { if constexpr (FP8) { _Pragma("unroll") for (int n = 0; n < 2; ++n) PG8_LD8(dst##8[n], PG8_SB(b, h) + boff + n * 2048); } else PG8_LDB_(dst, b, h); } while (0)
#define PG8_LDA_(dst, b, h) do { _Pragma("unroll") for (int m = 0; m < 4; ++m) _Pragma("unroll") for (int k = 0; k < 2; ++k) dst[m][k] = *(const LAS bf16x8*)(lds + PG8_SA(b, h) + aoff + m * 2048 + k * 1024); } while (0)
#define PG8_LDB_(dst, b, h) do { _Pragma("unroll") for (int n = 0; n < 2; ++n) _Pragma("unroll") for (int k = 0; k < 2; ++k) dst[n][k] = *(const LAS bf16x8*)(lds + PG8_SB(b, h) + boff + n * 2048 + k * 1024); } while (0)
#define PG8_MMA(ai, bj, At, Bt) do { if constexpr (FP8) __builtin_amdgcn_sched_barrier(0); __builtin_amdgcn_s_setprio(1); _Pragma("unroll") for (int m = 0; m < 4; ++m) _Pragma("unroll") for (int n = 0; n < 2; ++n) { \
        if constexpr (FP8) { asm volatile("v_mfma_scale_f32_16x16x128_f8f6f4 %0, %1, %2, %0, %3, %3 op_sel_hi:[0,0,0]" : "+v"(acc[ai][bj][m][n]) : "v"(Bt##8[n]), "v"(At##8[m]), "v"(sc8)); } \
        else { _Pragma("unroll") for (int k = 0; k < 2; ++k) acc[ai][bj][m][n] = __builtin_amdgcn_mfma_f32_16x16x32_bf16(Bt[n][k], At[m][k], acc[ai][bj][m][n], 0, 0, 0); } } \
        __builtin_amdgcn_s_setprio(0); if constexpr (FP8) __builtin_amdgcn_sched_barrier(0); } while (0)
#define PG8_WAIT_V(n) asm volatile("s_waitcnt vmcnt(" #n ")" ::: "memory")
#define PG8_WAIT_L(n) asm volatile("s_waitcnt lgkmcnt(" #n ")" ::: "memory")
#define PG8_BAR __builtin_amdgcn_s_barrier()
#define PG8_SCHED __builtin_amdgcn_sched_barrier(0)
#define PG8_SETA(v, u) do { _Pragma("unroll") for (int _h = 0; _h < 2; ++_h) _Pragma("unroll") for (int _i = 0; _i < 2; ++_i) { const int _row = Rr[_i] + 128 * _h; \
        int _t = _row; if (GATHER) { _t = (_row < (u).cnt) ? (u).tok[_row] : 0; } v[_h][_i] = (unsigned)(_t * K + Cc[_i]) * 2u; } } while (0)
    Unit cur, nxt; int ui = 0;
    if (!S.next(0, cur)) return;
    f32x4 acc[2][2][4][2];
#pragma unroll
    for (int a = 0; a < 2; ++a)
#pragma unroll
        for (int b = 0; b < 2; ++b)
#pragma unroll
            for (int m = 0; m < 4; ++m)
#pragma unroll
                for (int n = 0; n < 2; ++n) acc[a][b][m][n] = (f32x4){0.f, 0.f, 0.f, 0.f};
    bf16x8 At[4][2], B0[2][2], B1[2][2];
    unsigned sc8 = 0x7F7F7F7Fu; asm volatile("" : "+v"(sc8));
    pg8_v8i At8[4], B08[2], B18[2];
    unsigned cvA[2][2], nvA[2][2];
    PG8_SETA(cvA, cur);
    const char* cA = cur.a; const char* cB = cur.b;
    PG8_STAGE(PG8_SB(0, 0), cB, voffB); PG8_STAGE(PG8_SB(0, 1), cB + hstep, voffB); PG8_STAGE(PG8_SA(0, 0), cA, cvA[0]); PG8_STAGE(PG8_SA(0, 1), cA, cvA[1]);
    if (wr == 1) PG8_BAR;
    PG8_WAIT_V(2); PG8_BAR;
    PG8_STAGE(PG8_SB(1, 0), cB + kstep, voffB); PG8_STAGE(PG8_SA(1, 0), cA + kstep, cvA[0]); PG8_STAGE(PG8_SB(1, 1), cB + hstep + kstep, voffB);
    PG8_WAIT_V(6); PG8_BAR;
    for (;;) {
        const bool has_next = S.next(ui + 1, nxt);
        if (has_next) { PG8_SETA(nvA, nxt); } else {
#pragma unroll
            for (int h = 0; h < 2; ++h)
#pragma unroll
                for (int i = 0; i < 2; ++i) nvA[h][i] = cvA[h][i]; }
        const char* nA = has_next ? nxt.a : cA; const char* nB = has_next ? nxt.b : cB;
        unsigned long long tk0_ = 0; if constexpr (TPROBE) tk0_ = __builtin_amdgcn_s_memrealtime();
        for (int t = 0; t < nt; t += 2) {
            const bool last = (t == nt - 2);
            if constexpr (HOOK) { if (t == (nt >> 1)) E.mid(acc, cur, wr, wc, fr, fq); }
            const char* a1 = cA + (size_t)(t + 1) * kstep;
            const char* a2 = last ? nA : cA + (size_t)(t + 2) * kstep; const char* b2 = last ? nB : cB + (size_t)(t + 2) * kstep;
            const char* a3 = a2 + kstep; const char* b3 = b2 + kstep;
            unsigned xv[2][2];
#pragma unroll
            for (int h = 0; h < 2; ++h)
#pragma unroll
                for (int i = 0; i < 2; ++i) xv[h][i] = last ? nvA[h][i] : cvA[h][i];
            PG8_LDB(B0, 0, 0); PG8_LDB(B1, 0, 1); PG8_SCHED; PG8_LDA(At, 0, 0); PG8_STAGE(PG8_SA(1, 1), a1, cvA[1]);
            PG8_WAIT_V(8); PG8_WAIT_L(0); PG8_BAR; PG8_MMA(0, 0, At, B0); PG8_MMA(0, 1, At, B1); PG8_BAR; PG8_SCHED;
            PG8_LDA(At, 0, 1); PG8_STAGE(PG8_SB(0, 0), b2, voffB); PG8_STAGE(PG8_SB(0, 1), b2 + hstep, voffB); PG8_STAGE(PG8_SA(0, 0), a2, xv[0]);
            PG8_WAIT_V(8); PG8_WAIT_L(0); PG8_BAR; PG8_MMA(1, 0, At, B0); PG8_MMA(1, 1, At, B1); PG8_BAR; PG8_SCHED;
            PG8_LDB(B0, 1, 0); PG8_LDB(B1, 1, 1); PG8_SCHED; PG8_LDA(At, 1, 0); PG8_STAGE(PG8_SA(0, 1), a2, xv[1]);
            PG8_WAIT_V(8); PG8_WAIT_L(0); PG8_BAR; PG8_MMA(0, 0, At, B0); PG8_MMA(0, 1, At, B1); PG8_BAR; PG8_SCHED;
            PG8_LDA(At, 1, 1); PG8_STAGE(PG8_SB(1, 0), b3, voffB); PG8_STAGE(PG8_SB(1, 1), b3 + hstep, voffB); PG8_STAGE(PG8_SA(1, 0), a3, xv[0]);
            PG8_WAIT_V(8); PG8_WAIT_L(0); PG8_BAR; PG8_MMA(1, 0, At, B0); PG8_MMA(1, 1, At, B1); PG8_BAR; PG8_SCHED;
        }
        if constexpr (TPROBE) { if (blockIdx.x == 0 && tid == 0) { volatile LAS unsigned long long* st_ = (volatile LAS unsigned long long*)(lds + 131072 + 4096 + 256); st_[0] = st_[0] + (__builtin_amdgcn_s_memrealtime() - tk0_); } }
        if constexpr (FP8) asm volatile("s_nop 15\n\ts_nop 15" ::: "memory");
        if (wr == 0) PG8_BAR;
        E(acc, cur, wr, wc, fr, fq);
        if (!has_next) break;
#pragma unroll
        for (int a = 0; a < 2; ++a)
#pragma unroll
            for (int b = 0; b < 2; ++b)
#pragma unroll
                for (int m = 0; m < 4; ++m)
#pragma unroll
                    for (int n = 0; n < 2; ++n) acc[a][b][m][n] = (f32x4){0.f, 0.f, 0.f, 0.f};
        cur = nxt; cA = nA; cB = nB; ++ui;
#pragma unroll
        for (int h = 0; h < 2; ++h)
#pragma unroll
            for (int i = 0; i < 2; ++i) cvA[h][i] = nvA[h][i];
        if (wr == 1) PG8_BAR;
    }
    PG8_WAIT_V(0);
    PG8_BAR;
#undef PG8_SA
#undef PG8_SB
#undef PG8_STAGE
#undef PG8_LDA
#undef PG8_LDA_
#undef PG8_LDB_
#undef PG8_LD8
#undef PG8_LDB
#undef PG8_MMA
#undef PG8_WAIT_V
#undef PG8_WAIT_L
#undef PG8_BAR
#undef PG8_SCHED
#undef PG8_SETA
}
}

typedef f32x4 AccT[2][2][4][2];

struct EpiInProj {
    bf16_t *Q, *Kp, *Vp, *Up, *G; const float *gq, *gk;
    __device__ __forceinline__ void operator()(const AccT& acc, const pg8::Unit& u, int wr, int wc, int fr, int fq) const {
        const int pn = u.pn, pm = u.pm, b = pm >> 4;
        const int row0 = pm * 256 + wr * 64 + fr, prow0 = row0 + 64 * (b + 1);
        const int d0 = 8 * fq;
        if (pn < 4) {
            const bool isq = pn < 2; const float* gv = isq ? gq : gk; const float sc = isq ? C2 : 1.0f;
            float g0[8], g1[8];
#pragma unroll
            for (int i = 0; i < 8; ++i) { g0[i] = gv[d0 + i] * sc; g1[i] = gv[32 + d0 + i] * sc; }
            bf16_t* base = (isq ? Q + (size_t)row0 * 512 : Kp + (size_t)prow0 * 512) + 64 * (4 * (pn & 1) + wc) + d0;
#pragma unroll
            for (int ai = 0; ai < 2; ++ai)
#pragma unroll
                for (int m = 0; m < 4; ++m) {
                    const f32x4 v00 = acc[ai][0][m][0], v01 = acc[ai][0][m][1], v10 = acc[ai][1][m][0], v11 = acc[ai][1][m][1];
                    float ss = 0.f;
#pragma unroll
                    for (int i = 0; i < 4; ++i) ss += v00[i] * v00[i] + v01[i] * v01[i] + v10[i] * v10[i] + v11[i] * v11[i];
                    ss += __shfl_xor(ss, 16); ss += __shfl_xor(ss, 32);
                    const float r = __builtin_amdgcn_rsqf(ss * (1.0f / 64.0f) + RMS_EPS);
                    bf16_t* rowp = base + (size_t)(ai * 128 + m * 16) * 512;
                    u32x4 w0, w1;
                    w0.x = cvt_pk_bf16(v00[0] * r * g0[0], v00[1] * r * g0[1]); w0.y = cvt_pk_bf16(v00[2] * r * g0[2], v00[3] * r * g0[3]);
                    w0.z = cvt_pk_bf16(v01[0] * r * g0[4], v01[1] * r * g0[5]); w0.w = cvt_pk_bf16(v01[2] * r * g0[6], v01[3] * r * g0[7]);
                    w1.x = cvt_pk_bf16(v10[0] * r * g1[0], v10[1] * r * g1[1]); w1.y = cvt_pk_bf16(v10[2] * r * g1[2], v10[3] * r * g1[3]);
                    w1.z = cvt_pk_bf16(v11[0] * r * g1[4], v11[1] * r * g1[5]); w1.w = cvt_pk_bf16(v11[2] * r * g1[6], v11[3] * r * g1[7]);
                    __builtin_nontemporal_store(w0, (u32x4*)(rowp)); __builtin_nontemporal_store(w1, (u32x4*)(rowp + 32));
                }
        } else if (pn < 8) {
            bf16_t* base = (pn < 6 ? Vp : Up) + (size_t)prow0 * 512 + 64 * (4 * (pn & 1) + wc) + d0;
#pragma unroll
            for (int ai = 0; ai < 2; ++ai)
#pragma unroll
                for (int m = 0; m < 4; ++m) { bf16_t* rowp = base + (size_t)(ai * 128 + m * 16) * 512;
#pragma unroll
                    for (int bj = 0; bj < 2; ++bj) { const f32x4 v0 = acc[ai][bj][m][0], v1 = acc[ai][bj][m][1]; u32x4 w;
                        w.x = cvt_pk_bf16(v0[0], v0[1]); w.y = cvt_pk_bf16(v0[2], v0[3]); w.z = cvt_pk_bf16(v1[0], v1[1]); w.w = cvt_pk_bf16(v1[2], v1[3]);
                        __builtin_nontemporal_store(w, (u32x4*)(rowp + 32 * bj)); } }
        }
    }
};
struct EpiGates8 {
    unsigned char* G;
    __device__ __forceinline__ void operator()(const AccT& acc, const pg8::Unit& u, int wr, int wc, int fr, int fq) const {
        unsigned char* base0 = G + (size_t)(((((u.pm * 4 + (u.pn >> 1)) * 4 + (u.pn & 1)) * 8 + wr) * 4 + wc) * 512 + (fr + 16 * fq) * 8); unsigned char* base1 = base0 + (size_t)MX * 1024;
#pragma unroll
        for (int ai = 0; ai < 2; ++ai)
#pragma unroll
            for (int m = 0; m < 4; ++m) { const size_t ro = (size_t)(ai * 32768 + m * 4096); unsigned q0[8], q1[8];
#pragma unroll
                for (int n = 0; n < 2; ++n)
#pragma unroll
                    for (int i = 0; i < 4; ++i) { const float s0 = fast_sigmoid(acc[ai][0][m][n][i] * (1.0f / 32.0f)), s1 = fast_sigmoid(acc[ai][1][m][n][i] * (1.0f / 32.0f));
                        q0[4 * n + i] = (unsigned)(s0 * 255.0f + 0.5f); q1[4 * n + i] = max(1u, (unsigned)(s1 * 255.0f + 0.5f)); }
                u32x2 w; w.x = q0[0] | (q0[1] << 8) | (q0[2] << 16) | (q0[3] << 24); w.y = q0[4] | (q0[5] << 8) | (q0[6] << 16) | (q0[7] << 24); __builtin_nontemporal_store(w, (u32x2*)(base0 + ro));
                w.x = q1[0] | (q1[1] << 8) | (q1[2] << 16) | (q1[3] << 24); w.y = q1[4] | (q1[5] << 8) | (q1[6] << 16) | (q1[7] << 24); __builtin_nontemporal_store(w, (u32x2*)(base1 + ro)); }
    }
};
struct EpiMerged {
    bf16_t* out; const unsigned char* g0q; const unsigned char* g1q;
    template <bool MID> __device__ __forceinline__ void apply(AccT& acc, const pg8::Unit& u, int wr, int wc, int fr, int fq) const {
        int row0 = u.pm * 256 + wr * 64 + fr, col0 = u.pn * 256 + wc * 32 + 8 * fq;
        int gbase = (u.pm * 4 + u.pn) * 65536 + wr * 2048 + wc * 512 + (fr + 16 * fq) * 8;
        asm volatile("" : "+v"(row0), "+v"(col0), "+v"(gbase));
        if (MID) {
            u32x2 a1[2][2][4], a0[2][2][4];
#pragma unroll
            for (int ai = 0; ai < 2; ++ai)
#pragma unroll
                for (int bj = 0; bj < 2; ++bj)
#pragma unroll
                    for (int m = 0; m < 4; ++m) { const size_t o = (size_t)(unsigned)(gbase + ai * 32768 + bj * 16384 + m * 4096); a1[ai][bj][m] = *(const u32x2*)(g1q + o); a0[ai][bj][m] = *(const u32x2*)(g0q + o); }
#pragma unroll
            for (int ai = 0; ai < 2; ++ai)
#pragma unroll
                for (int bj = 0; bj < 2; ++bj)
#pragma unroll
                    for (int m = 0; m < 4; ++m) { f32x4 v0 = acc[ai][bj][m][0], v1 = acc[ai][bj][m][1];
#pragma unroll
                        for (int k = 0; k < 4; ++k) { const float d0 = (float)((a1[ai][bj][m].x >> (8 * k)) & 0xffu), d1 = (float)((a1[ai][bj][m].y >> (8 * k)) & 0xffu);
                            v0[k] *= (float)((a0[ai][bj][m].x >> (8 * k)) & 0xffu) * __builtin_amdgcn_rcpf(d0); v1[k] *= (float)((a0[ai][bj][m].y >> (8 * k)) & 0xffu) * __builtin_amdgcn_rcpf(d1); }
                        acc[ai][bj][m][0] = v0; acc[ai][bj][m][1] = v1; }
            asm volatile("" ::: "memory");
        } else {
            u32x2 a1[2][2][4];
#pragma unroll
            for (int ai = 0; ai < 2; ++ai)
#pragma unroll
                for (int bj = 0; bj < 2; ++bj)
#pragma unroll
                    for (int m = 0; m < 4; ++m) a1[ai][bj][m] = *(const u32x2*)(g1q + (size_t)(unsigned)(gbase + ai * 32768 + bj * 16384 + m * 4096));
#pragma unroll
            for (int ai = 0; ai < 2; ++ai)
#pragma unroll
                for (int bj = 0; bj < 2; ++bj)
#pragma unroll
                    for (int m = 0; m < 4; ++m) { f32x4 v0 = acc[ai][bj][m][0], v1 = acc[ai][bj][m][1]; const u32x2 g = a1[ai][bj][m];
#pragma unroll
                        for (int k = 0; k < 4; ++k) { v0[k] *= (float)((g.x >> (8 * k)) & 0xffu) * (1.0f / 255.0f); v1[k] *= (float)((g.y >> (8 * k)) & 0xffu) * (1.0f / 255.0f); }
                        u32x4 w; w.x = cvt_pk_bf16(v0[0], v0[1]); w.y = cvt_pk_bf16(v0[2], v0[3]); w.z = cvt_pk_bf16(v1[0], v1[1]); w.w = cvt_pk_bf16(v1[2], v1[3]);
                        *(u32x4*)(out + (size_t)(row0 + ai * 128 + m * 16) * 1024 + col0 + bj * 128) = w; }
        }
    }
    __device__ __forceinline__ void mid(AccT& acc, const pg8::Unit& u, int wr, int wc, int fr, int fq) const { apply<true>(acc, u, wr, wc, fr, fq); }
    __device__ __forceinline__ void operator()(const AccT& acc, const pg8::Unit& u, int wr, int wc, int fr, int fq) const { apply<false>(const_cast<AccT&>(acc), u, wr, wc, fr, fq); }
};
struct EpiResid {
    const float* rinv; bf16_t* h1b; float* ssq; unsigned char* h1b8;
    __device__ __forceinline__ void operator()(const AccT& acc, const pg8::Unit& u, int wr, int wc, int fr, int fq) const {
        const int row0 = u.pm * 256 + wr * 64 + fr, col0 = u.pn * 256 + wc * 32 + 8 * fq;
        float ri[2][4];
#pragma unroll
        for (int ai = 0; ai < 2; ++ai)
#pragma unroll
            for (int m = 0; m < 4; ++m) ri[ai][m] = rinv[(size_t)(row0 + ai * 128 + m * 16)];
#pragma unroll
        for (int ai = 0; ai < 2; ++ai) {
            u32x4 xv[4][2];
#pragma unroll
            for (int m = 0; m < 4; ++m)
#pragma unroll
                for (int bj = 0; bj < 2; ++bj) xv[m][bj] = *(const u32x4*)(h1b + (size_t)(row0 + ai * 128 + m * 16) * 1024 + col0 + bj * 128);
#pragma unroll
            for (int m = 0; m < 4; ++m) { const size_t r = (size_t)(row0 + ai * 128 + m * 16); float ss = 0.f; const float rm = ri[ai][m];
#pragma unroll
                for (int bj = 0; bj < 2; ++bj) { const u32x4 h = xv[m][bj]; const f32x4 a0 = acc[ai][bj][m][0], a1 = acc[ai][bj][m][1];
                    const f32x4 v0 = {bf_lo(h.x) * rm + a0[0], bf_hi(h.x) * rm + a0[1], bf_lo(h.y) * rm + a0[2], bf_hi(h.y) * rm + a0[3]}, v1 = {bf_lo(h.z) * rm + a1[0], bf_hi(h.z) * rm + a1[1], bf_lo(h.w) * rm + a1[2], bf_hi(h.w) * rm + a1[3]};
                    ss += (v0[0] * v0[0] + v0[1] * v0[1]) + (v0[2] * v0[2] + v0[3] * v0[3]) + (v1[0] * v1[0] + v1[1] * v1[1]) + (v1[2] * v1[2] + v1[3] * v1[3]);
                    u32x4 w; w.x = cvt_pk_bf16(v0[0], v0[1]); w.y = cvt_pk_bf16(v0[2], v0[3]); w.z = cvt_pk_bf16(v1[0], v1[1]); w.w = cvt_pk_bf16(v1[2], v1[3]);
                    *(u32x4*)(h1b + r * 1024 + col0 + bj * 128) = w;
                    u32x2 w8 = {0u, 0u};
                    w8.x = __builtin_amdgcn_cvt_pk_fp8_f32(v0[0], v0[1], w8.x, false); w8.x = __builtin_amdgcn_cvt_pk_fp8_f32(v0[2], v0[3], w8.x, true);
                    w8.y = __builtin_amdgcn_cvt_pk_fp8_f32(v1[0], v1[1], w8.y, false); w8.y = __builtin_amdgcn_cvt_pk_fp8_f32(v1[2], v1[3], w8.y, true);
                    *(u32x2*)(h1b8 + r * 1024 + col0 + bj * 128) = w8; }
                ss += __shfl_xor(ss, 16); ss += __shfl_xor(ss, 32);
                if (fq == 0) ssq[r * 16 + u.pn * 4 + wc] = ss; }
        }
    }
};
constexpr float HH_SCALE = 16.0f;
struct EpiSwiGLU {
    bf16_t* HH; const float* rs; const float* cw;
    __device__ __forceinline__ void operator()(const AccT& acc, const pg8::Unit& u, int wr, int wc, int fr, int fq) const {
        const int lr0 = wr * 64 + fr, col0 = u.pn * 128 + wc * 32 + 8 * fq;
        float rv[2][4], cv[2][4];
#pragma unroll
        for (int ai = 0; ai < 2; ++ai)
#pragma unroll
            for (int m = 0; m < 4; ++m) { const int lr = lr0 + ai * 128 + m * 16; const bool valid = lr < u.cnt; const int ix = u.aux + (valid ? lr : 0);
                const float r = rs[ix] * (1.0f / 32.0f), c = cw[ix]; rv[ai][m] = r; cv[ai][m] = valid ? c * r * r * HH_SCALE : 0.f; }
#pragma unroll
        for (int ai = 0; ai < 2; ++ai)
#pragma unroll
            for (int m = 0; m < 4; ++m) { const int lr = lr0 + ai * 128 + m * 16; const float nr = -rv[ai][m] * LOG2E, k = cv[ai][m];
                float o[8];
#pragma unroll
                for (int n = 0; n < 2; ++n)
#pragma unroll
                    for (int i = 0; i < 4; ++i) { const float a1 = acc[ai][0][m][n][i], a3 = acc[ai][1][m][n][i];
                        o[4 * n + i] = a1 * a3 * k * __builtin_amdgcn_rcpf(1.0f + __builtin_amdgcn_exp2f(a1 * nr)); }
                u32x2 w = {0u, 0u};
                w.x = __builtin_amdgcn_cvt_pk_fp8_f32(o[0], o[1], w.x, false); w.x = __builtin_amdgcn_cvt_pk_fp8_f32(o[2], o[3], w.x, true);
                w.y = __builtin_amdgcn_cvt_pk_fp8_f32(o[4], o[5], w.y, false); w.y = __builtin_amdgcn_cvt_pk_fp8_f32(o[6], o[7], w.y, true);
                *(u32x2*)((unsigned char*)HH + (size_t)(u.hrow + lr) * 256 + col0) = w; }
    }
};
template <bool FINAL> struct EpiScatter {
    bf16_t* hb; float* out; const int* tok;
    __device__ __forceinline__ void operator()(const AccT& acc, const pg8::Unit& u, int wr, int wc, int fr, int fq) const {
        const int lr0 = wr * 64 + fr, col0 = u.pn * 256 + wc * 32 + 8 * fq;
        int tk[2][4]; bool ok[2][4];
#pragma unroll
        for (int ai = 0; ai < 2; ++ai)
#pragma unroll
            for (int m = 0; m < 4; ++m) { const int lr = lr0 + ai * 128 + m * 16; ok[ai][m] = lr < u.cnt; tk[ai][m] = tok[u.aux + (ok[ai][m] ? lr : 0)]; }
#pragma unroll
        for (int ai = 0; ai < 2; ++ai) {
            u32x4 hv[4][2];
#pragma unroll
            for (int m = 0; m < 4; ++m)
#pragma unroll
                for (int bj = 0; bj < 2; ++bj) hv[m][bj] = *(const u32x4*)(hb + (size_t)tk[ai][m] * 1024 + col0 + bj * 128);
#pragma unroll
            for (int m = 0; m < 4; ++m) if (ok[ai][m]) {
#pragma unroll
                for (int bj = 0; bj < 2; ++bj) { const u32x4 h = hv[m][bj]; const f32x4 a0 = acc[ai][bj][m][0] * (1.0f / (32.0f * HH_SCALE)), a1 = acc[ai][bj][m][1] * (1.0f / (32.0f * HH_SCALE));
                    const f32x4 v0 = {bf_lo(h.x) + a0[0], bf_hi(h.x) + a0[1], bf_lo(h.y) + a0[2], bf_hi(h.y) + a0[3]}, v1 = {bf_lo(h.z) + a1[0], bf_hi(h.z) + a1[1], bf_lo(h.w) + a1[2], bf_hi(h.w) + a1[3]};
                    if (FINAL) { float* p = out + (size_t)tk[ai][m] * 1024 + col0 + bj * 128; *(f32x4*)p = v0; *(f32x4*)(p + 4) = v1; }
                    else { u32x4 w; w.x = cvt_pk_bf16(v0[0], v0[1]); w.y = cvt_pk_bf16(v0[2], v0[3]); w.z = cvt_pk_bf16(v1[0], v1[1]); w.w = cvt_pk_bf16(v1[2], v1[3]); *(u32x4*)(hb + (size_t)tk[ai][m] * 1024 + col0 + bj * 128) = w; } } }
        }
    }
};

template <int NSUB, bool G1, int ES = 2> struct MoeOrder {
    const volatile LAS int* pre; const volatile LAS int* cnt; int l0, nl, stride, first; const char* A; const char* W; const int* tok; int id0, id1;
    __device__ bool next(int i, pg8::Unit& u) const {
        const int id = id0 + i * stride + first; if (id1 >= 0 && id >= id1) return false; const int t0 = __builtin_amdgcn_readfirstlane(pre[l0]), total = (__builtin_amdgcn_readfirstlane(pre[l0 + nl]) - t0) * NSUB; if (id >= total) return false;
        const int tile = t0 + id / NSUB, sub = id % NSUB; int l = l0; { int hi_ = l0 + nl; while (hi_ - l > 1) { const int mid_ = (l + hi_) >> 1; if (tile >= pre[mid_]) l = mid_; else hi_ = mid_; } }
        l = __builtin_amdgcn_readfirstlane(l);
        const int mt = __builtin_amdgcn_readfirstlane(tile - pre[l]), e = l & 31;
        u.pm = mt; u.pn = sub; u.cnt = __builtin_amdgcn_readfirstlane(min(256, cnt[l] - mt * 256)); u.aux = l * LCAP + mt * 256; u.hrow = tile * 256; u.tok = tok + u.aux;
        if (G1) { u.a = A; u.b = W + ((size_t)e * 512 + (size_t)sub * 256) * 1024; }
        else    { u.a = A + (size_t)tile * 256 * 256 * ES; u.b = W + ((size_t)e * 1024 + (size_t)sub * 256) * 256 * ES; }
        return true;
    }
};

namespace attn_body {
using bf16 = __hip_bfloat16;
using bf16x8 = __attribute__((ext_vector_type(8))) short;
using s16x4 = __attribute__((ext_vector_type(4))) short;
using f32x16 = __attribute__((ext_vector_type(16))) float;
using u32x4 = __attribute__((ext_vector_type(4))) unsigned;
constexpr int D = 64, DM = 512, ODM = 1024;
constexpr int NW = 8, QBLK = 32, QB = QBLK * NW, KVBLK = 64;
__device__ __forceinline__ int crow(int r, int hi) { return (r & 3) + 8 * (r >> 2) + 4 * hi; }
#define SBAR() __builtin_amdgcn_sched_barrier(0)
__device__ __forceinline__ void cmask(f32x16& p0, f32x16& p1, int jb, int qrel, int hi) {
    const float NEG = -INFINITY; int kb = 64 * jb + 4 * hi;
#pragma unroll
    for (int r = 0; r < 16; ++r) { int kv = kb + (r & 3) + 8 * (r >> 2); if (kv > qrel) p0[r] = NEG; if (kv + 32 > qrel) p1[r] = NEG; }
}
constexpr int NSLOT = 3, SLOTB = 8192;
constexpr int LDS_K = 0, LDS_V = NSLOT * SLOTB, LDS_WS = 2 * NSLOT * SLOTB, LDS_OST = LDS_WS + NW * 64 * 4, LDS_KB = LDS_OST + NW * 4096, LDS_KBR = LDS_KB + LP * 4, LDS_BYTES = LDS_KBR + LP * 4;
__device__ __forceinline__ void glds16(const void* gsrc, unsigned lds_dst) { unsigned keep;
    asm volatile("s_mov_b32 %0, m0\n\ts_mov_b32 m0, %2\n\ts_nop 0\n\tglobal_load_lds_dwordx4 %1, off\n\ts_mov_b32 m0, %0" : "=&s"(keep) : "v"(gsrc), "s"(lds_dst) : "memory"); }
typedef float f32x2_t __attribute__((ext_vector_type(2))); typedef __bf16 bf16x2_t __attribute__((ext_vector_type(2)));
__device__ __forceinline__ unsigned cvtpk_s(float lo, float hi) { f32x2_t v = {lo, hi}; bf16x2_t b = __builtin_convertvector(v, bf16x2_t); return __builtin_bit_cast(unsigned, b); }
#define WAIT_BAR(N) asm volatile("s_waitcnt vmcnt(" #N ") lgkmcnt(0)\n\ts_barrier" ::: "memory")
typedef __attribute__((address_space(3))) const char* lds_cptr;
typedef __attribute__((address_space(3))) const float* lds_fptr;
typedef short v4i16_t __attribute__((ext_vector_type(4)));
__device__ __forceinline__ void cinit(f32x16& c0, f32x16& c1, lds_fptr kb, int hi) {
#pragma unroll
    for (int g = 0; g < 4; ++g) { const f32x4 a = *(const LAS f32x4*)(kb + 8 * g + 4 * hi), b = *(const LAS f32x4*)(kb + 32 + 8 * g + 4 * hi);
#pragma unroll
        for (int i = 0; i < 4; ++i) { c0[4 * g + i] = a[i]; c1[4 * g + i] = b[i]; } }
}
__device__ __forceinline__ void qkt(f32x16& p0, f32x16& p1, const char* Kslot, const bf16x8* qr, const f32x16& c0, const f32x16& c1, int r32, int hi) {
    const char* kb = Kslot + hi * 1024 + r32 * 16;
#pragma unroll
    for (int d0 = 0; d0 < 4; ++d0) {
        const bf16x8 b0 = *reinterpret_cast<const bf16x8*>(kb + d0 * 2048);
        const bf16x8 b1 = *reinterpret_cast<const bf16x8*>(kb + d0 * 2048 + 512);
        if (d0 == 0) { p0 = __builtin_amdgcn_mfma_f32_32x32x16_bf16(b0, qr[0], c0, 0, 0, 0); p1 = __builtin_amdgcn_mfma_f32_32x32x16_bf16(b1, qr[0], c1, 0, 0, 0); }
        else { p0 = __builtin_amdgcn_mfma_f32_32x32x16_bf16(b0, qr[d0], p0, 0, 0, 0); p1 = __builtin_amdgcn_mfma_f32_32x32x16_bf16(b1, qr[d0], p1, 0, 0, 0); } }
}
__device__ __forceinline__ void kload8(bf16x8* kf, lds_cptr kp) {
    kf[0] = *(const LAS bf16x8*)(kp);        kf[1] = *(const LAS bf16x8*)(kp + 512);
    kf[2] = *(const LAS bf16x8*)(kp + 2048); kf[3] = *(const LAS bf16x8*)(kp + 2560);
    kf[4] = *(const LAS bf16x8*)(kp + 4096); kf[5] = *(const LAS bf16x8*)(kp + 4608);
    kf[6] = *(const LAS bf16x8*)(kp + 6144); kf[7] = *(const LAS bf16x8*)(kp + 6656);
}
__device__ __forceinline__ void kload2(bf16x8* kf, lds_cptr kp, int j) { kf[2 * j] = *(const LAS bf16x8*)(kp + j * 2048); kf[2 * j + 1] = *(const LAS bf16x8*)(kp + j * 2048 + 512); }
__device__ __forceinline__ s16x4 vtr(lds_cptr p) { return __builtin_bit_cast(s16x4, __builtin_amdgcn_ds_read_tr16_b64_v4i16((LAS v4i16_t*)p)); }
__device__ __forceinline__ void pv(f32x16* o, int vb, bf16x8 pa0, bf16x8 pa1, bf16x8 pa2, bf16x8 pa3) {
#pragma unroll
    for (int d0 = 0; d0 < 2; ++d0) { s16x4 lo[4], hi[4];
#pragma unroll
        for (int ks = 0; ks < 4; ++ks) {
            asm volatile("ds_read_b64_tr_b16 %0,%1 offset:%c2" : "=&v"(lo[ks]) : "v"(vb), "i"(d0 * 4096 + ks * 1024) : "memory");
            asm volatile("ds_read_b64_tr_b16 %0,%1 offset:%c2" : "=&v"(hi[ks]) : "v"(vb), "i"(d0 * 4096 + ks * 1024 + 512) : "memory"); }
        asm volatile("s_waitcnt lgkmcnt(0)" ::: "memory"); SBAR();
#define PK(k) (bf16x8){lo[k][0], lo[k][1], lo[k][2], lo[k][3], hi[k][0], hi[k][1], hi[k][2], hi[k][3]}
        o[d0] = __builtin_amdgcn_mfma_f32_32x32x16_bf16(pa0, PK(0), o[d0], 0, 0, 0);
        o[d0] = __builtin_amdgcn_mfma_f32_32x32x16_bf16(pa1, PK(1), o[d0], 0, 0, 0);
        o[d0] = __builtin_amdgcn_mfma_f32_32x32x16_bf16(pa2, PK(2), o[d0], 0, 0, 0);
        o[d0] = __builtin_amdgcn_mfma_f32_32x32x16_bf16(pa3, PK(3), o[d0], 0, 0, 0);
#undef PK
    }
}
template <int THRL> __device__ __forceinline__ void attn_unit(int b, int h, int qb, const bf16* Q, const bf16* __restrict__ K, const bf16* __restrict__ V, bf16* O, char* shm, const int wave_s, const float cb) {
    int tid_ = wave_s * 64 + lane_id(); asm volatile("" : "+v"(tid_));
    const int tid = tid_, lane = tid & 63, r32 = lane & 31, hi = lane >> 5; const int wid = wave_s;
    const int q0 = qb * QB;
    const bf16* Qw = Q + ((long)b * SEQ_ + q0 + wid * QBLK) * DM + h * D;
    const bf16 *Kh = K + (long)b * LP * DM + h * D, *Vh = V + (long)b * LP * DM + h * D;
    const unsigned lds0 = (unsigned)(uintptr_t)shm;
    const bf16* ksrc = Kh + (long)lane * DM + wid * 8;
    const bf16* vsrc = Vh + (long)(16 * (wid & 3) + (lane >> 2)) * DM + (wid >> 2) * 32 + (lane & 3) * 8;
    const unsigned kdst = lds0 + LDS_K + wid * 1024, vdst = lds0 + LDS_V + wid * 1024;
#define DMA_K(t, slot) glds16(ksrc + (long)(t) * KVBLK * DM, (unsigned)__builtin_amdgcn_readfirstlane(kdst + (slot)))
#define DMA_V(t, slot) glds16(vsrc + (long)(t) * KVBLK * DM, (unsigned)__builtin_amdgcn_readfirstlane(vdst + (slot)))
    const int vb0 = (int)(lds0 + LDS_V) + ((lane >> 4) & 1) * 32 + (lane & 3) * 8 + (4 * hi + ((lane & 15) >> 2)) * 64;
    const char* Kbase = shm + LDS_K; bf16x8 kf[8];
    const lds_cptr shm3 = (lds_cptr)shm; const lds_cptr kp0 = shm3 + LDS_K + hi * 1024 + r32 * 16; const lds_cptr vp0 = shm3 + LDS_V + ((lane >> 4) & 1) * 32 + (lane & 3) * 8 + (4 * hi + ((lane & 15) >> 2)) * 64;
    const lds_fptr kbl = (lds_fptr)(shm3 + LDS_KB); const lds_fptr kbr = (lds_fptr)(shm3 + LDS_KBR);
    const int NT = 4 * qb + 5;
    DMA_K(0, 0); DMA_V(0, 0); DMA_K(1, SLOTB);
    { const float rref = kbl[64 + q0 + 128] + cb;
      LAS float* kw = (LAS float*)(shm3 + LDS_KBR);
      for (int i = tid; i < 64 * NT; i += 512) kw[i] = kbl[i] - rref; }
    bf16x8 qr[4];
#pragma unroll
    for (int d0 = 0; d0 < 4; ++d0) qr[d0] = *reinterpret_cast<const bf16x8*>(&Qw[(long)r32 * DM + d0 * 16 + hi * 8]);
    const int qrel = wid * QBLK + r32;
    f32x16 o[2]; o[0] = f32x16{}; o[1] = f32x16{}; f32x16 lacc = f32x16{};
    bf16x8 ones; { const short one = (short)0x3F80; ones = (bf16x8){one, one, one, one, one, one, one, one}; asm volatile("" : "+v"(ones)); }
#define CMASK(P0, P1, t) do { int jb_ = (t) - (NT - 4); if (jb_ >= 0) cmask(P0, P1, jb_, qrel, hi); } while (0)
    f32x16 pA0, pA1, pB0, pB1;
    int sl_prev = 0, sl_cur = 0, sl_next = SLOTB;
#define ROT() do { sl_prev = sl_cur; sl_cur = sl_next; sl_next = (sl_next == (NSLOT - 1) * SLOTB) ? 0 : sl_next + SLOTB; } while (0)
    DMA_K(2, 2 * SLOTB);
    WAIT_BAR(3);
    { f32x16 ci0, ci1; cinit(ci0, ci1, kbr, hi);
      qkt(pB0, pB1, Kbase, qr, ci0, ci1, r32, hi); }
    CMASK(pB0, pB1, 0);
    _Pragma("unroll") for (int r = 0; r < 16; ++r) { pB0[r] = __builtin_amdgcn_exp2f(pB0[r]); pB1[r] = __builtin_amdgcn_exp2f(pB1[r]); }
    WAIT_BAR(0);
    DMA_K(3, 0); DMA_V(1, SLOTB);
    ROT();
    kload8(kf, kp0 + sl_cur);
    WAIT_BAR(2);
    s16x4 vlo[8], vhi[8]; u32x4 pw0, pw1, pw2, pw3;
#define PKW(P, B) cvtpk_s(P[B], P[B + 1])
#define PAF(k) __builtin_bit_cast(bf16x8, pw##k)
#define VFR(i) (bf16x8){vlo[i][0], vlo[i][1], vlo[i][2], vlo[i][3], vhi[i][0], vhi[i][1], vhi[i][2], vhi[i][3]}
#define PIN(x) asm volatile("" : "+v"(x))
#define GAPA(MF, W0, W1, PW) do { MF; W0; W1; PIN(PW); } while (0)
#define EX(v) __builtin_amdgcn_exp2f(v)
#define GAPB3(MF, X, B) do { MF; X[B] = EX(X[B]); X[B + 1] = EX(X[B + 1]); X[B + 2] = EX(X[B + 2]); PIN(X); SBAR(); } while (0)
#define GAPL(k, X, B) do { lacc = __builtin_amdgcn_mfma_f32_32x32x16_bf16(PAF(k), ones, lacc, 0, 0, 0); X[B] = EX(X[B]); PIN(X); SBAR(); } while (0)
#define GAPL2(k, X, B, Y, B2) do { lacc = __builtin_amdgcn_mfma_f32_32x32x16_bf16(PAF(k), ones, lacc, 0, 0, 0); X[B] = EX(X[B]); Y[B2] = EX(Y[B2]); PIN(X); PIN(Y); SBAR(); } while (0)
#define VRD(i) do { vlo[i] = vtr(vp_ + (((i) >> 2) * 4096 + ((i) & 3) * 1024)); vhi[i] = vtr(vp_ + (((i) >> 2) * 4096 + ((i) & 3) * 1024 + 512)); } while (0)
#define KRD(G, j) do { if (G) { kload2(kf, kp0 + sl_next, j); } } while (0)
#define STEP(C0, C1, P0, P1, t, GK, GV, GL) do { SBAR(); \
    const lds_cptr vp_ = vp0 + sl_prev; \
    f32x16 ci0_, ci1_; cinit(ci0_, ci1_, kbr + 64 * (t), hi); SBAR(); \
    VRD(0); \
    GAPA(C0 = __builtin_amdgcn_mfma_f32_32x32x16_bf16(kf[0], qr[0], ci0_, 0, 0, 0), pw0[0] = PKW(P0, 0), pw0[1] = PKW(P0, 2), pw0); \
    VRD(4); GAPA(C1 = __builtin_amdgcn_mfma_f32_32x32x16_bf16(kf[1], qr[0], ci1_, 0, 0, 0), pw0[2] = PKW(P0, 4), pw0[3] = PKW(P0, 6), pw0); \
    VRD(1); GAPA(C0 = __builtin_amdgcn_mfma_f32_32x32x16_bf16(kf[2], qr[1], C0, 0, 0, 0),   pw1[0] = PKW(P0, 8), pw1[1] = PKW(P0, 10), pw1); \
    VRD(5); GAPA(C1 = __builtin_amdgcn_mfma_f32_32x32x16_bf16(kf[3], qr[1], C1, 0, 0, 0),   pw1[2] = PKW(P0, 12), pw1[3] = PKW(P0, 14), pw1); \
    VRD(2); GAPA(C0 = __builtin_amdgcn_mfma_f32_32x32x16_bf16(kf[4], qr[2], C0, 0, 0, 0),   pw2[0] = PKW(P1, 0), pw2[1] = PKW(P1, 2), pw2); \
    VRD(6); GAPA(C1 = __builtin_amdgcn_mfma_f32_32x32x16_bf16(kf[5], qr[2], C1, 0, 0, 0),   pw2[2] = PKW(P1, 4), pw2[3] = PKW(P1, 6), pw2); \
    VRD(3); GAPA(C0 = __builtin_amdgcn_mfma_f32_32x32x16_bf16(kf[6], qr[3], C0, 0, 0, 0),   pw3[0] = PKW(P1, 8), pw3[1] = PKW(P1, 10), pw3); \
    VRD(7); GAPA(C1 = __builtin_amdgcn_mfma_f32_32x32x16_bf16(kf[7], qr[3], C1, 0, 0, 0),   pw3[2] = PKW(P1, 12), pw3[3] = PKW(P1, 14), pw3); \
    if (GK) { DMA_K((t) + 3, sl_cur); } if (GV) { DMA_V((t) + 1, sl_next); } \
    CMASK(C0, C1, t); \
    SBAR(); \
    GAPB3(o[0] = __builtin_amdgcn_mfma_f32_32x32x16_bf16(PAF(0), VFR(0), o[0], 0, 0, 0), C0, 0); \
    GAPB3(o[1] = __builtin_amdgcn_mfma_f32_32x32x16_bf16(PAF(0), VFR(4), o[1], 0, 0, 0), C0, 3); \
    GAPL2(0, C0, 6, C0, 7); \
    KRD(GL, 0); GAPB3(o[0] = __builtin_amdgcn_mfma_f32_32x32x16_bf16(PAF(1), VFR(1), o[0], 0, 0, 0), C0, 8); \
    KRD(GL, 1); GAPB3(o[1] = __builtin_amdgcn_mfma_f32_32x32x16_bf16(PAF(1), VFR(5), o[1], 0, 0, 0), C0, 11); \
    GAPL2(1, C0, 14, C0, 15); \
    KRD(GL, 2); GAPB3(o[0] = __builtin_amdgcn_mfma_f32_32x32x16_bf16(PAF(2), VFR(2), o[0], 0, 0, 0), C1, 0); \
    KRD(GL, 3); GAPB3(o[1] = __builtin_amdgcn_mfma_f32_32x32x16_bf16(PAF(2), VFR(6), o[1], 0, 0, 0), C1, 3); \
    GAPL2(2, C1, 6, C1, 7); \
    GAPB3(o[0] = __builtin_amdgcn_mfma_f32_32x32x16_bf16(PAF(3), VFR(3), o[0], 0, 0, 0), C1, 8); \
    GAPB3(o[1] = __builtin_amdgcn_mfma_f32_32x32x16_bf16(PAF(3), VFR(7), o[1], 0, 0, 0), C1, 11); \
    GAPL2(3, C1, 14, C1, 15); \
    } while (0)
#define ENDW(tt) do { if ((tt) + 3 < NT) { WAIT_BAR(2); } else if ((tt) + 2 < NT) { WAIT_BAR(1); } else { WAIT_BAR(0); } } while (0)
    STEP(pA0, pA1, pB0, pB1, 1, (1 + 3 < NT), (1 + 1 < NT), (1 + 1 < NT)); ENDW(1); ROT();
    int t = 2;
#undef CMASK
#define CMASK(P0, P1, t) do { } while (0)
    for (; t + 5 < NT; t += 2) {
        STEP(pB0, pB1, pA0, pA1, t, true, true, true);       WAIT_BAR(2); ROT();
        STEP(pA0, pA1, pB0, pB1, t + 1, true, true, true);   WAIT_BAR(2); ROT();
    }
#undef CMASK
#define CMASK(P0, P1, t) do { int jb_ = (t) - (NT - 4); if (jb_ >= 0) cmask(P0, P1, jb_, qrel, hi); } while (0)
    for (; t + 1 < NT; t += 2) {
        STEP(pB0, pB1, pA0, pA1, t, (t + 3 < NT), (t + 1 < NT), (t + 1 < NT));         ENDW(t);     ROT();
        STEP(pA0, pA1, pB0, pB1, t + 1, (t + 4 < NT), (t + 2 < NT), (t + 2 < NT));     ENDW(t + 1); ROT();
    }
    STEP(pB0, pB1, pA0, pA1, NT - 1, false, false, false);
    { pw0 = (u32x4){PKW(pB0, 0), PKW(pB0, 2), PKW(pB0, 4), PKW(pB0, 6)}; pw1 = (u32x4){PKW(pB0, 8), PKW(pB0, 10), PKW(pB0, 12), PKW(pB0, 14)}; pw2 = (u32x4){PKW(pB1, 0), PKW(pB1, 2), PKW(pB1, 4), PKW(pB1, 6)}; pw3 = (u32x4){PKW(pB1, 8), PKW(pB1, 10), PKW(pB1, 12), PKW(pB1, 14)};
      SBAR(); pv(o, vb0 + sl_cur, PAF(0), PAF(1), PAF(2), PAF(3));
      lacc = __builtin_amdgcn_mfma_f32_32x32x16_bf16(PAF(0), ones, lacc, 0, 0, 0); lacc = __builtin_amdgcn_mfma_f32_32x32x16_bf16(PAF(1), ones, lacc, 0, 0, 0);
      lacc = __builtin_amdgcn_mfma_f32_32x32x16_bf16(PAF(2), ones, lacc, 0, 0, 0); lacc = __builtin_amdgcn_mfma_f32_32x32x16_bf16(PAF(3), ones, lacc, 0, 0, 0); }
#undef PKW
#undef PAF
#undef VFR
#undef PIN
#undef GAPA
#undef GAPB3
#undef GAPL
#undef GAPL2
#undef EX
#undef VRD
#undef KRD
#undef STEP
#undef ENDW
    bf16* Ow = O + ((long)b * SEQ_ + q0 + wid * QBLK) * ODM + h * D;
    { bf16* stg = (bf16*)(shm + LDS_OST) + wid * 2048;
#pragma unroll
      for (int r = 0; r < 16; ++r) { const int orow = crow(r, hi); const float rl = __builtin_amdgcn_rcpf(lacc[r]);
#pragma unroll
        for (int d0 = 0; d0 < 2; ++d0) stg[orow * 64 + d0 * 32 + r32] = __float2bfloat16(o[d0][r] * rl); }
      asm volatile("s_waitcnt lgkmcnt(0)" ::: "memory");
#pragma unroll
      for (int i = 0; i < 4; ++i) { const int row = i * 8 + (lane >> 3), ch = lane & 7; const u32x4 v = *(const u32x4*)(stg + row * 64 + ch * 8); *(u32x4*)(Ow + (long)row * ODM + ch * 8) = v; } }
    asm volatile("s_waitcnt lgkmcnt(0)\n\ts_barrier" ::: "memory");
#undef DMA_K
#undef DMA_V
#undef CMASK
#undef ROT
}
#undef SBAR
#undef WAIT_BAR
}


#define XB_TMO      128
#define XB_XCNT(j)  (256  + 64 * (j))
#define XB_XSUB(j)  (1280 + 64 * (j))
#define XB_XGEN(j)  (2304 + 64 * (j))
#define XB_TOP      3328
#define XB_TOPGEN   3392
#define XCD_BAR_WORDS 3456
#define XB_SPIN_CAP (1u << 18)
__device__ __forceinline__ unsigned xb_ld(unsigned* p)              { return __hip_atomic_load(p, __ATOMIC_RELAXED, __HIP_MEMORY_SCOPE_AGENT); }
__device__ __forceinline__ unsigned xb_add(unsigned* p, unsigned v) { return __hip_atomic_fetch_add(p, v, __ATOMIC_RELAXED, __HIP_MEMORY_SCOPE_AGENT); }
__device__ __forceinline__ unsigned xb_xcc_id() { return (unsigned)__builtin_amdgcn_s_getreg((3 << 11) | 20) & 0xFu; }
#define XB_SPIN(cond, bar) do { unsigned _sp = 0; while (cond) { __builtin_amdgcn_s_sleep(1); \
    if ((++_sp & 255u) == 0u) { if (xb_ld(&(bar)[XB_TMO])) break; if (_sp > XB_SPIN_CAP) { atomicAdd(&(bar)[XB_TMO], 1u); break; } } } } while (0)
__device__ __forceinline__ void xcd_barrier_post(unsigned* bar, const int wave_s) { if (wave_s == 0 && lane_id() == 0) (void)xb_add(&bar[XB_XCNT(xb_xcc_id())], 1u); }
__device__ __forceinline__ void xcd_barrier_complete(unsigned* bar, unsigned x, unsigned& nloc, unsigned& nx) {
    const unsigned G = gridDim.x * gridDim.y * gridDim.z;
    unsigned sum, cnt, mine, sp = 0u;
    for (;;) {
        sum = 0u; cnt = 0u; mine = 0u;
#pragma unroll
        for (unsigned j = 0; j < 16; ++j) { const unsigned c = xb_ld(&bar[XB_XCNT(j)]); sum += c; cnt += (c > 0u) ? 1u : 0u; mine = (j == x) ? c : mine; }
        if (sum == G) break;
        __builtin_amdgcn_s_sleep(1);
        if ((++sp & 255u) == 0u) { if (xb_ld(&bar[XB_TMO])) break; if (sp > XB_SPIN_CAP) { atomicAdd(&bar[XB_TMO], 1u); break; } }
    }
    nloc = mine > 0u ? mine : 1u; nx = cnt > 0u ? cnt : 1u;
}
struct XbNoWork { __device__ __forceinline__ void operator()() const {} };
template <class Work = XbNoWork>
__device__ __forceinline__ void xcd_barrier(unsigned* bar, volatile LAS unsigned* st, const int wave_s, const Work& work = Work()) {
    asm volatile("s_waitcnt vmcnt(0)" ::: "memory");
    __syncthreads();
    if (wave_s != 0) work();
    if (wave_s == 0 && lane_id() == 0) {
        const unsigned x = xb_xcc_id();
        __builtin_amdgcn_s_waitcnt(0);
        unsigned nloc = st[0], nx = st[1];
        if (nloc == 0u) { xcd_barrier_complete(bar, x, nloc, nx); st[0] = nloc; st[1] = nx; }
        const unsigned old = xb_add(&bar[XB_XSUB(x)], 1u);
        const unsigned gen = old / nloc;
        if (old + 1u == (gen + 1u) * nloc) {
            __builtin_amdgcn_fence(__ATOMIC_RELEASE, "agent");
            asm volatile("s_waitcnt vmcnt(0)" ::: "memory");
            const unsigned og = xb_add(&bar[XB_TOP], 1u);
            const unsigned tg = og / nx;
            if (og + 1u == (tg + 1u) * nx) xb_add(&bar[XB_TOPGEN], 1u);
            else XB_SPIN(xb_ld(&bar[XB_TOPGEN]) == tg, bar);
            __builtin_amdgcn_fence(__ATOMIC_ACQUIRE, "agent");
            xb_add(&bar[XB_XGEN(x)], 1u);
            asm volatile("s_waitcnt vmcnt(0)" ::: "memory");
        } else {
            XB_SPIN(xb_ld(&bar[XB_XGEN(x)]) == gen, bar);
            __builtin_amdgcn_fence(__ATOMIC_ACQUIRE, "agent");
            asm volatile("s_waitcnt vmcnt(0)" ::: "memory");
        }
    }
    __syncthreads();
}

struct Args {
    const float *x, *meta, *g_mix, *w_in, *b_forget, *gq, *gk, *w_up_attn, *w_pool, *pool_scale, *w_up_pool, *w_out, *g_ffn, *w_group, *b_group, *w_router, *b_router, *w1, *w3, *w2;
    float* out; unsigned char* ws;
};

__device__ __forceinline__ unsigned f2bf(float f) { unsigned u = __builtin_bit_cast(unsigned, f); return (u + 0x7fffu + ((u >> 16) & 1u)) >> 16; }
__device__ __forceinline__ unsigned pk2(float lo, float hi) { return f2bf(lo) | (f2bf(hi) << 16); }

constexpr int N_DEF_ = 3 * 4096;
struct TItem { const float* src; const float* ks; bf16_t* WT; int ldw, Kdim, k0, n0, row_off, mode; };
__device__ __forceinline__ void tp_load(const TItem& t, int lane, float (&v)[32]) {
    int sc0 = t.n0;
    if (t.mode == 1 || t.mode == 3) { if (t.n0 >= 2048) { const int L0 = t.n0 & 255; sc0 = 2056 + 1024 * ((L0 >> 5) & 1) + 128 * ((t.n0 - 2048) >> 8) + 32 * (L0 >> 6); } else if (t.n0 >= 1536) sc0 = t.n0 + 8; }
    const float* wp = t.src + (size_t)(t.k0 + (lane >> 5)) * t.ldw + sc0 + (lane & 31);
#pragma unroll
    for (int i = 0; i < 32; ++i) v[i] = __builtin_nontemporal_load(&wp[(size_t)(2 * i) * t.ldw]);
}
__device__ __forceinline__ void tp_finish(const TItem& t, int lane, float (&v)[32], LAS float* scr) {
    if (t.ks) {
#pragma unroll
        for (int i = 0; i < 32; ++i) v[i] *= t.ks[t.k0 + 2 * i + (lane >> 5)]; }
#pragma unroll
    for (int i = 0; i < 32; ++i) scr[(2 * i + (lane >> 5)) * 33 + (lane & 31)] = v[i];
    asm volatile("s_waitcnt lgkmcnt(0)" ::: "memory");
    const int c = lane & 7;
    if (t.mode == 4 || t.mode == 5) {
#pragma unroll
        for (int j = 0; j < 4; ++j) { const int nn = (lane >> 3) + 8 * j, n = t.n0 + nn; const LAS float* sp = scr + (8 * c) * 33 + nn;
            const int dr = (t.mode == 5) ? t.row_off + n : t.row_off + 256 * (n >> 7) + (n & 127);
            u32x2 o = {0u, 0u};
            o.x = __builtin_amdgcn_cvt_pk_fp8_f32(sp[0 * 33] * 32.f, sp[1 * 33] * 32.f, o.x, false); o.x = __builtin_amdgcn_cvt_pk_fp8_f32(sp[2 * 33] * 32.f, sp[3 * 33] * 32.f, o.x, true);
            o.y = __builtin_amdgcn_cvt_pk_fp8_f32(sp[4 * 33] * 32.f, sp[5 * 33] * 32.f, o.y, false); o.y = __builtin_amdgcn_cvt_pk_fp8_f32(sp[6 * 33] * 32.f, sp[7 * 33] * 32.f, o.y, true);
            *(u32x2*)((unsigned char*)t.WT + (size_t)dr * t.Kdim + t.k0 + 8 * c) = o; }
        asm volatile("s_waitcnt lgkmcnt(0)" ::: "memory");
        return; }
    if (t.mode == 3) {
#pragma unroll
        for (int j = 0; j < 4; ++j) { const int nn = (lane >> 3) + 8 * j, n = t.n0 + nn; const LAS float* sp = scr + (8 * c) * 33 + nn; const int L = n & 255;
            const int dr = ((n & ~255) - 2048) + 128 * ((L & 63) >> 5) + 32 * (L >> 6) + (L & 31);
            u32x2 o = {0u, 0u};
            o.x = __builtin_amdgcn_cvt_pk_fp8_f32(sp[0 * 33] * 32.f, sp[1 * 33] * 32.f, o.x, false); o.x = __builtin_amdgcn_cvt_pk_fp8_f32(sp[2 * 33] * 32.f, sp[3 * 33] * 32.f, o.x, true);
            o.y = __builtin_amdgcn_cvt_pk_fp8_f32(sp[4 * 33] * 32.f, sp[5 * 33] * 32.f, o.y, false); o.y = __builtin_amdgcn_cvt_pk_fp8_f32(sp[6 * 33] * 32.f, sp[7 * 33] * 32.f, o.y, true);
            *(u32x2*)((unsigned char*)t.WT + (size_t)dr * 1024 + t.k0 + 8 * c) = o; }
        asm volatile("s_waitcnt lgkmcnt(0)" ::: "memory");
        return; }
#pragma unroll
    for (int j = 0; j < 4; ++j) { const int nn = (lane >> 3) + 8 * j, n = t.n0 + nn; const LAS float* sp = scr + (8 * c) * 33 + nn;
        u32x4 o; o.x = pk2(sp[0 * 33], sp[1 * 33]); o.y = pk2(sp[2 * 33], sp[3 * 33]); o.z = pk2(sp[4 * 33], sp[5 * 33]); o.w = pk2(sp[6 * 33], sp[7 * 33]);
        int dr;
        if (t.mode == 0) dr = t.row_off + n;
        else if (t.mode == 1) { const int L = n & 255; dr = (n & ~255) + 128 * ((L & 63) >> 5) + 32 * (L >> 6) + (L & 31); }
        else dr = t.row_off + 256 * (n >> 7) + (n & 127);
        *(u32x4*)(t.WT + (size_t)dr * t.Kdim + t.k0 + 8 * c) = o; }
    asm volatile("s_waitcnt lgkmcnt(0)" ::: "memory");
}

template <int NR> __device__ __forceinline__ void p0_rows_load(const float* const (&xrow)[NR], int ln, f32x4 (&v)[NR][4]) {
#pragma unroll
    for (int r = 0; r < NR; ++r)
#pragma unroll
        for (int j = 0; j < 4; ++j) v[r][j] = __builtin_nontemporal_load(&((const f32x4*)xrow[r])[64 * j + ln]);
}
template <int NR, bool W8> __device__ __forceinline__ void p0_rows(const f32x4 (&v)[NR][4], bf16_t* ob, unsigned char* ob8, const int (&mrow)[NR], const LAS float* wf, int ln, float (&zo)[NR], float (&rso)[NR]) {
    float ss[NR], z[NR][8];
#pragma unroll
    for (int r = 0; r < NR; ++r) { ss[r] = 0.f;
#pragma unroll
        for (int h = 0; h < 8; ++h) z[r][h] = 0.f; }
#pragma unroll
    for (int j = 0; j < 4; ++j) {
#pragma unroll
        for (int r = 0; r < NR; ++r) ss[r] += (v[r][j].x * v[r][j].x + v[r][j].y * v[r][j].y) + (v[r][j].z * v[r][j].z + v[r][j].w * v[r][j].w);
#pragma unroll
        for (int h = 0; h < 8; ++h) { const f32x4 w = *(const LAS f32x4*)(wf + h * 1024 + 256 * j + 4 * ln);
#pragma unroll
            for (int r = 0; r < NR; ++r) z[r][h] += (v[r][j].x * w.x + v[r][j].y * w.y) + (v[r][j].z * w.z + v[r][j].w * w.w); }
        __builtin_amdgcn_sched_barrier(0); }
    const bool b5 = (ln & 32) != 0, b4 = (ln & 16) != 0, b3 = (ln & 8) != 0;
#pragma unroll
    for (int r = 0; r < NR; ++r) {
        const float rstd = 1.0f / sqrtf(wave_sum(ss[r]) * (1.f / DM_) + RMS_EPS);
        unsigned long long* o8 = (unsigned long long*)(ob + (size_t)mrow[r] * DM_) + ln; unsigned* o4 = (unsigned*)(ob8 + (size_t)mrow[r] * DM_) + ln;
#pragma unroll
        for (int j = 0; j < 4; ++j) { const f32x4 y = v[r][j] * rstd; o8[64 * j] = (unsigned long long)pk2(y.x, y.y) | ((unsigned long long)pk2(y.z, y.w) << 32);
            if constexpr (W8) { unsigned w8 = 0u; w8 = __builtin_amdgcn_cvt_pk_fp8_f32(y.x, y.y, w8, false); w8 = __builtin_amdgcn_cvt_pk_fp8_f32(y.z, y.w, w8, true); o4[64 * j] = w8; } }
        float a[4], bq[2];
#pragma unroll
        for (int i = 0; i < 4; ++i) { const float send = b5 ? z[r][i] : z[r][4 + i], keep = b5 ? z[r][4 + i] : z[r][i]; a[i] = keep + __shfl_xor(send, 32); }
#pragma unroll
        for (int i = 0; i < 2; ++i) { const float send = b4 ? a[i] : a[2 + i], keep = b4 ? a[2 + i] : a[i]; bq[i] = keep + __shfl_xor(send, 16); }
        float c = (b3 ? bq[1] : bq[0]) + __shfl_xor(b3 ? bq[0] : bq[1], 8);
        c += __shfl_xor(c, 4); c += __shfl_xor(c, 2); c += __shfl_xor(c, 1);
        zo[r] = c * rstd;
        rso[r] = rstd;
    }
}
__device__ __forceinline__ float log_sigmoid_f(float z) { return fminf(z, 0.f) - log1pf(expf(-fabsf(z))); }

__device__ __forceinline__ int bx_f() { int b = (int)blockIdx.x; asm volatile("" : "+s"(b)); return b; }
__device__ __forceinline__ int grid_f() { int g = (int)gridDim.x; asm volatile("" : "+s"(g)); return g; }
__device__ __forceinline__ int vcu_f() { const int g = grid_f(), b = bx_f(); return (g % 8 == 0) ? (b % 8) * (g / 8) + b / 8 : b; }
typedef const Args __attribute__((address_space(4)))* KArgsP;
__device__ __forceinline__ KArgsP kargs() { KArgsP p = (KArgsP)__builtin_amdgcn_kernarg_segment_ptr(); asm volatile("" : "+s"(p)); return p; }
__global__ void __launch_bounds__(512, 2) fwd_megakernel(Args args_unused) {
    extern __shared__ __attribute__((aligned(16))) unsigned char lds[];
    LAS unsigned char* L = (LAS unsigned char*)lds;
    const int wave = __builtin_amdgcn_readfirstlane(threadIdx.x >> 6);
#define tid (wave * 64 + lane_id())
#define lane lane_id()
#define G grid_f()
#define bx bx_f()
#define vcu vcu_f()
#define WSP(T, off) ((T*)(KA->ws + (off)))
#define ctl WSP(unsigned, WS_CTL)
#define Wmain WSP(bf16_t, WS_WMAIN)
#define Wg8 WSP(unsigned char, WS_WG8)
#define HN8 WSP(unsigned char, WS_HN8)
#define H1B8 WSP(unsigned char, WS_H1B8)
#define Wa WSP(bf16_t, WS_WA)
#define We WSP(bf16_t, WS_WE)
#define Wout WSP(bf16_t, WS_WOUT)
#define Wr WSP(bf16_t, WS_WR)
#define HNM WSP(bf16_t, WS_HNM)
#define LF WSP(float, WS_LF)
#define SSQ WSP(float, WS_SSQ)
#define RINV WSP(float, WS_RINV)
#define W13 WSP(bf16_t, WS_W13)
#define W2t WSP(bf16_t, WS_W2)
#define TOK WSP(int, WS_TOK)
#define RS WSP(float, WS_RS)
#define CWt WSP(float, WS_CW)
#define HN WSP(bf16_t, WS_RA)
#define YP WSP(bf16_t, WS_RA)
#define H1B WSP(bf16_t, WS_RA)
#define Gt WSP(bf16_t, WS_RB)
#define HH WSP(bf16_t, WS_RB)
#define Qb WSP(bf16_t, WS_Q)
#define Kb WSP(bf16_t, WS_K)
#define Vb WSP(bf16_t, WS_V)
#define Ub WSP(bf16_t, WS_U)
#define MG WSP(bf16_t, WS_MG)
#define Ob WSP(bf16_t, WS_O)
#define MIX WSP(bf16_t, WS_MIX)
#define gw (vcu * 8 + wave)
#define NGW (G * 8)
#define STAMP(k) do { if (PROBE_PHASE >= 0 && ((k) == PROBE_PHASE || (k) == PROBE_PHASE + 1) && blockIdx.x == 0 && wave == 0 && lane_id() == 0) ((volatile LAS unsigned long long*)(L + LDSX_OFF + 4096))[k] = __builtin_amdgcn_s_memrealtime(); } while (0)
    STAMP(0);
    volatile LAS unsigned* xbst = (volatile LAS unsigned*)(L + LDSX_OFF + 8192);
    if (wave == 0 && lane_id() < 2) xbst[lane_id()] = 0u;
    __syncthreads();
    { const KArgsP KA = kargs(); xcd_barrier_post(ctl + CW_XBAR, wave); }
#define GRID_BAR() do { const KArgsP KA = kargs(); xcd_barrier(ctl + CW_XBAR, xbst, wave); } while (0)
#define DEF_ITEM(t, r_) do { int r = (r_); if (r < 4096) { const int e = r / 128, q = r % 128; t = TItem{KA->w1 + (size_t)e * 1024 * 256, KA->g_ffn, W13, 256, 1024, 64 * (q / 8), 32 * (q % 8), e * 512, 4}; } \
        else if (r < 8192) { r -= 4096; const int e = r / 128, q = r % 128; t = TItem{KA->w3 + (size_t)e * 1024 * 256, KA->g_ffn, W13, 256, 1024, 64 * (q / 8), 32 * (q % 8), e * 512 + 128, 4}; } \
        else { r -= 8192; const int e = r / 128, q = r % 128; t = TItem{KA->w2 + (size_t)e * 256 * 1024, nullptr, W2t, 1024, 256, 64 * (q / 32), 32 * (q % 32), e * 1024, 5}; } } while (0)
#define GRID_BAR_D(start, end) do { const KArgsP KA = kargs(); xcd_barrier(ctl + CW_XBAR, xbst, wave, [&]() { LAS float* scr = (LAS float*)(L + wave * 16384); \
        for (int r0 = (start) + vcu * 7 + (wave - 1); r0 < (end); r0 += 2 * G * 7) { const int r1 = r0 + G * 7; const bool hb = r1 < (end);     \
            TItem ta, tb; float va[32], vb[32]; \
            DEF_ITEM(ta, r0); tp_load(ta, lane, va); if (hb) { DEF_ITEM(tb, r1); tp_load(tb, lane, vb); } \
            tp_finish(ta, lane, va, scr); if (hb) tp_finish(tb, lane, vb, scr); } }); } while (0)

    if (PH(0)) {
        const KArgsP KA = kargs();
        LAS float* wf = (LAS float*)L;
        for (int k = tid; k < 1024; k += 512) { const f32x4 a = *(const f32x4*)(KA->w_in + (size_t)k * 4104 + 1536), b = *(const f32x4*)(KA->w_in + (size_t)k * 4104 + 1540); const float g = KA->g_mix[k];
            wf[k] = a.x * g; wf[1024 + k] = a.y * g; wf[2048 + k] = a.z * g; wf[3072 + k] = a.w * g; wf[4096 + k] = b.x * g; wf[5120 + k] = b.y * g; wf[6144 + k] = b.z * g; wf[7168 + k] = b.w * g; }
        __syncthreads();
        {
            const int ln = lane;
            const float bfh = KA->b_forget[ln >> 3];
            f32x4 va[4][4], vb[4][4];
#define P0_ROWPTRS(it_, xr_, orow_, mm_) do { _Pragma("unroll") for (int r = 0; r < 4; ++r) { mm_[r] = gw + (4 * (it_) + r) * NGW; xr_[r] = KA->x + (size_t)mm_[r] * DM_; orow_[r] = HN + (size_t)mm_[r] * DM_; } } while (0)
#define P0_ROWFIN(v_, orow_, mm_) do { float zo[4], rso[4]; p0_rows<4, true>(v_, HN, HN8, mm_, wf, ln, zo, rso); \
                if (ln == 0) { _Pragma("unroll") for (int r = 0; r < 4; ++r) RINV[mm_[r]] = 1.0f / rso[r]; } \
                if ((ln & 7) == 0) { _Pragma("unroll") for (int r = 0; r < 4; ++r) { const int b = mm_[r] >> 12, t = mm_[r] & 4095; LF[(size_t)(b * 8 + (ln >> 3)) * LP + 64 + t] = log_sigmoid_f(zo[r] + bfh); } } } while (0)
            { const float* xr[4]; bf16_t* oa[4]; bf16_t* ob[4]; int ma[4], mb[4];
              P0_ROWPTRS(0, xr, oa, ma); p0_rows_load<4>(xr, ln, va);
              P0_ROWPTRS(1, xr, ob, mb); p0_rows_load<4>(xr, ln, vb);
              P0_ROWFIN(va, oa, ma);
              P0_ROWPTRS(2, xr, oa, ma); p0_rows_load<4>(xr, ln, va);
              P0_ROWFIN(vb, ob, mb);
              P0_ROWPTRS(3, xr, ob, mb); p0_rows_load<4>(xr, ln, vb);
              P0_ROWFIN(va, oa, ma);
              P0_ROWFIN(vb, ob, mb); }
#undef P0_ROWPTRS
#undef P0_ROWFIN
            if (gw < NMETA) {
                const float* xr[1] = {KA->meta + (size_t)gw * DM_}; bf16_t* orow[1] = {HNM + (size_t)gw * DM_}; float zo[1], rso[1]; f32x4 v1[1][4];
                const int m1[1] = {0}; p0_rows_load<1>(xr, ln, v1); p0_rows<1, false>(v1, HNM + (size_t)gw * DM_, nullptr, m1, wf, ln, zo, rso);
                if ((ln & 7) == 0) { const float v = log_sigmoid_f(zo[0] + bfh);
#pragma unroll
                    for (int b = 0; b < NBATCH; ++b) LF[(size_t)(b * 8 + (ln >> 3)) * LP + 48 + gw] = v; }
            }
        }
        for (int i = bx * 512 + tid; i < 64 * 48; i += G * 512) LF[(size_t)(i / 48) * LP + (i % 48)] = 0.f;
        for (int i = bx * 512 + tid; i < NBATCH * 48 * 64; i += G * 512) { const int b = i / (48 * 64), r = (i / 64) % 48, c = (i % 64) * 8; const size_t off = ((size_t)(b * LP + r)) * 512 + c; const u32x4 z = {0u, 0u, 0u, 0u};
            *(u32x4*)(Kb + off) = z; *(u32x4*)(Vb + off) = z; *(u32x4*)(Ub + off) = z; }
        for (int i = bx * 512 + tid; i < 48 * 1024; i += G * 512) { const int j = i >> 10, k = i & 1023; float v = 0.f;
            if (j < 4) v = KA->w_group[k * 4 + j] * KA->g_ffn[k]; else if (j < 36) v = KA->w_router[k * 32 + (j - 4)] * KA->g_ffn[k];
            Wr[i] = (bf16_t)f2bf(v); }
        __syncthreads();
        LAS float* scr = (LAS float*)(L + wave * 16384);
        constexpr int I_MAIN = 16 * 128, I_WA = 8 * 32, I_WOUT = 16 * 32, I_W1 = NEXP * 16 * 8, I_W2 = NEXP * 4 * 32, I_WE = 4 * 32 * 16;
        constexpr int NITEMS = I_MAIN + I_WA + I_WOUT + 2 * I_W1 + I_W2 + I_WE;
        constexpr int NTR = I_MAIN + I_WA + I_WOUT;
        auto make_item = [&](int r) -> TItem {
            TItem t;
            if (r < I_MAIN) { const int n0 = 32 * (r % 128); t = TItem{KA->w_in, KA->g_mix, n0 >= 2048 ? (bf16_t*)Wg8 : Wmain, 4104, 1024, 64 * (r / 128), n0, 0, n0 >= 2048 ? 3 : 1}; return t; } r -= I_MAIN;
            if (r < I_WA) { t = TItem{KA->w_up_attn, nullptr, Wa, 1024, 1024, 64 * (r / 32), 32 * (r % 32), 0, 0}; return t; } r -= I_WA;
            if (r < I_WOUT) { t = TItem{KA->w_out, nullptr, Wout, 1024, 1024, 64 * (r / 32), 32 * (r % 32), 0, 0}; return t; } r -= I_WOUT;
            if (r < I_W1) { const int e = r / 128, q = r % 128; t = TItem{KA->w1 + (size_t)e * 1024 * 256, KA->g_ffn, W13, 256, 1024, 64 * (q / 8), 32 * (q % 8), e * 512, 4}; return t; } r -= I_W1;
            if (r < I_W1) { const int e = r / 128, q = r % 128; t = TItem{KA->w3 + (size_t)e * 1024 * 256, KA->g_ffn, W13, 256, 1024, 64 * (q / 8), 32 * (q % 8), e * 512 + 128, 4}; return t; } r -= I_W1;
            { const int e = r / 128, q = r % 128; t = TItem{KA->w2 + (size_t)e * 256 * 1024, nullptr, W2t, 1024, 256, 64 * (q / 32), 32 * (q % 32), e * 1024, 0}; return t; }
        };
        {
            const int ln = lane; float va[32], vb[32]; int it = gw;
            if (it < NTR) { TItem a = make_item(it); tp_load(a, ln, va);
                for (;;) {
                    const int itb = it + NGW; const bool hb = itb < NTR; TItem b = a; if (hb) { b = make_item(itb); tp_load(b, ln, vb); }
                    tp_finish(a, ln, va, scr); if (!hb) break;
                    const int ita = itb + NGW; const bool ha = ita < NTR; if (ha) { a = make_item(ita); tp_load(a, ln, va); }
                    tp_finish(b, ln, vb, scr); if (!ha) break;
                    it = ita; } }
        }
        for (int it = gw; it < I_WE; it += NGW) {
            const int r = it;
            {
                const int g = r / 512, cq = (r / 16) % 32, nb = r % 16, n = nb * 64 + lane;
                float a0 = 0.f, a1 = 0.f, a2 = 0.f, a3 = 0.f;
                const float* wp = KA->w_pool + ((size_t)g * 128 + cq * 4) * 128;
#pragma unroll 16
                for (int d = 0; d < 128; ++d) { const float wu = KA->w_up_pool[(size_t)(g * 128 + d) * 1024 + n] * KA->pool_scale[g * 128 + d];
                    a0 += wp[d] * wu; a1 += wp[128 + d] * wu; a2 += wp[256 + d] * wu; a3 += wp[384 + d] * wu; }
                u32x2 o; o.x = pk2(a0, a1); o.y = pk2(a2, a3);
                *(u32x2*)(Wa + (size_t)n * 1024 + 512 + g * 128 + cq * 4) = o;
            }
        }
    }
    GRID_BAR_D(0, 3584);
    STAMP(1);

    if (PH(1)) {
        const KArgsP KA = kargs();
        if (bx < 24) {
            const int item = bx, typ = item >> 3, hh = item & 7, pn = 2 + 2 * typ + (hh >> 2), wcc = hh & 3;
            f32x4 c4[4] = {{0.f, 0.f, 0.f, 0.f}, {0.f, 0.f, 0.f, 0.f}, {0.f, 0.f, 0.f, 0.f}, {0.f, 0.f, 0.f, 0.f}};
            const int ln = lane, r16 = ln & 15, q4 = ln >> 4;
            bf16x8 af[4], bfr[4][4];
#pragma unroll
            for (int k4 = 0; k4 < 4; ++k4) { const int kk = wave * 4 + k4; af[k4] = *(const bf16x8*)(HNM + (size_t)r16 * 1024 + kk * 32 + 8 * q4);
#pragma unroll
                for (int ct = 0; ct < 4; ++ct) { const int d = ct * 16 + r16;
                    bfr[k4][ct] = *(const bf16x8*)(Wmain + (size_t)(256 * pn + 128 * (d >> 5) + 32 * wcc + (d & 31)) * 1024 + kk * 32 + 8 * q4); } }
#pragma unroll
            for (int k4 = 0; k4 < 4; ++k4)
#pragma unroll
                for (int ct = 0; ct < 4; ++ct) c4[ct] = __builtin_amdgcn_mfma_f32_16x16x32_bf16(af[k4], bfr[k4][ct], c4[ct], 0, 0, 0);
            LAS f32x4* red = (LAS f32x4*)L;
#pragma unroll
            for (int ct = 0; ct < 4; ++ct) red[(wave * 4 + ct) * 64 + ln] = c4[ct];
            __syncthreads();
            if (wave == 0) {
#pragma unroll
                for (int ct = 0; ct < 4; ++ct) { f32x4 a = red[ct * 64 + ln];
#pragma unroll
                    for (int w = 1; w < 8; ++w) a += red[(w * 4 + ct) * 64 + ln];
                    c4[ct] = a; }
#pragma unroll
                for (int reg = 0; reg < 4; ++reg) {
                    float v[4]; float ss = 0.f;
#pragma unroll
                    for (int ct = 0; ct < 4; ++ct) { v[ct] = c4[ct][reg]; ss += v[ct] * v[ct]; }
                    ss += __shfl_xor(ss, 1); ss += __shfl_xor(ss, 2); ss += __shfl_xor(ss, 4); ss += __shfl_xor(ss, 8);
                    const float rn = (typ == 0) ? __builtin_amdgcn_rsqf(ss * (1.f / 64.f) + RMS_EPS) : 1.f;
                    bf16_t* dst = (typ == 0 ? Kb : (typ == 1 ? Vb : Ub));
                    const int mi = 4 * q4 + reg;
#pragma unroll
                    for (int ct = 0; ct < 4; ++ct) { const int d = ct * 16 + r16; const float o = (typ == 0) ? v[ct] * rn * KA->gk[d] : v[ct]; const bf16_t ob = (bf16_t)f2bf(o);
#pragma unroll
                        for (int b = 0; b < NBATCH; ++b) dst[((size_t)(b * LP + 48 + mi)) * 512 + 64 * hh + d] = ob; }
                }
            }
            __syncthreads();
        }
#define P1A_RUN() do { pg8::GridOrder S; S.init(HN, Wmain, MX, 2048, 1024, G, bx); EpiInProj E{Qb, Kb, Vb, Ub, Gt, KA->gq, KA->gk}; pg8::gemm_phase<EpiInProj, pg8::GridOrder, false>(L, 1024, S, E, wave); } while (0)
        if ((bx_f() & 7) < 4) P1A_RUN();
        { pg8::GridOrder S; S.init(HN8, Wg8, MX, 2048, 512, G, bx);
          EpiGates8 E{(unsigned char*)Gt};
          pg8::gemm_phase<EpiGates8, pg8::GridOrder, false, false, false, true>(L, 512, S, E, wave); }
        if ((bx_f() & 7) >= 4) P1A_RUN();
#undef P1A_RUN
    }
    GRID_BAR_D(3584, 5376);
    STAMP(2);

    if (PH(2)) {
        const KArgsP KA = kargs();
        for (int id = bx * 512 + tid; id < (MX / 16) * 64; id += G * 512) {
            const int rb = id >> 6, ch = id & 63, w = 2 << (ch >> 4), m0 = rb * 16;
            const size_t prow0 = (size_t)m0 + 64 * ((m0 >> 12) + 1);
            const bf16_t* up = Ub + prow0 * 512 + ch * 8;
            float sm[8] = {0.f, 0.f, 0.f, 0.f, 0.f, 0.f, 0.f, 0.f};
#define UNPK(f, v) const float f[8] = {bf_lo(v.x), bf_hi(v.x), bf_lo(v.y), bf_hi(v.y), bf_lo(v.z), bf_hi(v.z), bf_lo(v.w), bf_hi(v.w)}
#pragma unroll
            for (int j = 1; j < 16; ++j) if (j < w) { const u32x4 v = *(const u32x4*)(up - (ptrdiff_t)j * 512); UNPK(f, v);
#pragma unroll
                for (int i = 0; i < 8; ++i) sm[i] += f[i]; }
            const float inv = 1.0f / (float)w;
#pragma unroll
            for (int r = 0; r < 16; ++r) {
                const u32x4 vc = *(const u32x4*)(up + (ptrdiff_t)r * 512), vo = *(const u32x4*)(up + (ptrdiff_t)(r - w + 1) * 512);
                UNPK(fc, vc); UNPK(fo, vo);
                float o8[8];
#pragma unroll
                for (int i = 0; i < 8; ++i) { sm[i] += fc[i]; o8[i] = sm[i] * inv - fc[i]; sm[i] -= fo[i]; }
                u32x4 o; o.x = pk2(o8[0], o8[1]); o.y = pk2(o8[2], o8[3]); o.z = pk2(o8[4], o8[5]); o.w = pk2(o8[6], o8[7]);
                *(u32x4*)(Ob + (size_t)(m0 + r) * 1024 + 512 + ch * 8) = o;
            }
#undef UNPK
        }
        const int bh = vcu >> 2, u4 = vcu & 3;
        LAS float* kb = (LAS float*)(L + attn_body::LDS_KB);
        LAS float* part = (LAS float*)(L + attn_body::LDS_WS);
        {
            const float* lf = LF + (size_t)bh * LP; float v[9]; float run = 0.f;
#pragma unroll
            for (int i = 0; i < 9; ++i) { const int p = tid * 9 + i; v[i] = (p < LP) ? lf[p] : 0.f; run += v[i]; v[i] = run; }
            float inc = run;
#pragma unroll
            for (int o = 1; o < 64; o <<= 1) { const float y = __shfl_up(inc, o); if (lane >= o) inc += y; }
            if (lane == 63) part[wave] = inc;
            if (wave == 0) { float ga = fabsf(KA->gq[lane]), gb = fabsf(KA->gk[lane]);
#pragma unroll
                for (int o = 1; o < 64; o <<= 1) { ga = fmaxf(ga, __shfl_xor(ga, o)); gb = fmaxf(gb, __shfl_xor(gb, o)); }
                if (lane == 0) part[8] = C2 * 64.0f * ga * gb * 1.01f; }
            __syncthreads();
            float base = inc - run;
            for (int w = 0; w < wave; ++w) base += part[w];
#pragma unroll
            for (int i = 0; i < 9; ++i) { const int p = tid * 9 + i; if (p < LP) kb[p] = (p < 48) ? -INFINITY : -(base + v[i]) * LOG2E; }
            __syncthreads();
        }
        if (vcu < 256) {
            const int b = bh >> 3, h = bh & 7;
            const float cbv = part[8];
            const int qbs[4] = {15 - u4, 11 - u4, 4 + u4, u4};
#pragma unroll 1
            for (int i = 0; i < 4; ++i) attn_body::attn_unit<8>(b, h, qbs[i], (const attn_body::bf16*)Qb, (const attn_body::bf16*)Kb, (const attn_body::bf16*)Vb, (attn_body::bf16*)Ob, (char*)lds, wave, cbv);
        }
    }
    GRID_BAR_D(5376, 8960);
    STAMP(3);

    if (PH(3)) {
        const KArgsP KA = kargs();
        pg8::GridOrder S; S.init(Ob, Wa, MX, 1024, 1024, G, bx); EpiMerged E{MG, (const unsigned char*)Gt, (const unsigned char*)Gt + (size_t)MX * 1024};
        pg8::gemm_phase<EpiMerged, pg8::GridOrder, false, true>(L, 1024, S, E, wave);
    }
    GRID_BAR_D(8960, 10752);
    STAMP(4);

    if (PH(4)) {
        const KArgsP KA = kargs();
        pg8::GridOrder S; S.init(MG, Wout, MX, 1024, 1024, G, bx); EpiResid E{RINV, H1B, SSQ, H1B8};
        if (PROBE_PHASE == 14 && blockIdx.x == 0 && threadIdx.x == 0) ((volatile LAS unsigned long long*)(L + LDSX_OFF + 4096 + 256))[0] = 0;
        pg8::gemm_phase<EpiResid, pg8::GridOrder, false, false, PROBE_PHASE == 14>(L, 1024, S, E, wave);
    }
    GRID_BAR_D(10752, N_DEF_);
    STAMP(5);

    if (PH(5)) {
        const KArgsP KA = kargs();
        constexpr int WRP = 2064;
        LAS unsigned char* WrL = L;
        LAS float* Lg = (LAS float*)(L + 100 * 1024) + wave * (16 * 48);
        LAS int* hist = (LAS int*)(L + LDSX_OFF);
        bf16x8 af[32];
        { const int m0 = bx * 128 + wave * 16, r16 = lane & 15, q4 = lane >> 4; const bf16_t* ap = H1B + (size_t)(m0 + r16) * 1024 + 8 * q4;
#pragma unroll
          for (int kk = 0; kk < 32; ++kk) af[kk] = *(const bf16x8*)(ap + kk * 32); }
        for (int i = tid; i < 48 * 128; i += 512) { const int r = i >> 7, c = i & 127; *(LAS u32x4*)(WrL + r * WRP + c * 16) = *(const u32x4*)(Wr + (size_t)r * 1024 + c * 8); }
        if (tid < 128) hist[tid] = 0;
        __syncthreads();
        int my_m = -1, l1 = 0, l2 = 0, r1 = 0, r2 = 0; float w1v = 0.f, w2v = 0.f, rstd = 0.f;
        for (int rb = bx; rb < MX / 128; rb += G) {
            const int m0 = rb * 128 + wave * 16, r16 = lane & 15, q4 = lane >> 4;
            f32x4 c3[3] = {{0.f, 0.f, 0.f, 0.f}, {0.f, 0.f, 0.f, 0.f}, {0.f, 0.f, 0.f, 0.f}};
            f32x4 sq4[4];
#pragma unroll
            for (int p = 0; p < 4; ++p) sq4[p] = *(const f32x4*)(SSQ + (size_t)(m0 + r16) * 16 + 4 * p);
            if (rb != bx) { const bf16_t* ap = H1B + (size_t)(m0 + r16) * 1024 + 8 * q4;
#pragma unroll
              for (int kk = 0; kk < 32; ++kk) af[kk] = *(const bf16x8*)(ap + kk * 32); }
#pragma unroll
            for (int kk = 0; kk < 32; ++kk) {
#pragma unroll
                for (int nt3 = 0; nt3 < 3; ++nt3) { const bf16x8 bb = *(const LAS bf16x8*)(WrL + (nt3 * 16 + r16) * WRP + (kk * 32 + 8 * q4) * 2);
                    c3[nt3] = __builtin_amdgcn_mfma_f32_16x16x32_bf16(af[kk], bb, c3[nt3], 0, 0, 0); }
            }
#pragma unroll
            for (int nt3 = 0; nt3 < 3; ++nt3)
#pragma unroll
                for (int reg = 0; reg < 4; ++reg) Lg[(4 * q4 + reg) * 48 + nt3 * 16 + r16] = c3[nt3][reg];
            asm volatile("s_waitcnt lgkmcnt(0)" ::: "memory");
            if (lane < 16) {
                const int m = m0 + lane; float ss = 0.f;
#pragma unroll
                for (int p = 0; p < 4; ++p) ss += (sq4[p].x + sq4[p].y) + (sq4[p].z + sq4[p].w);
                rstd = 1.0f / sqrtf(ss * (1.f / DM_) + RMS_EPS);
                const LAS float* lg = Lg + lane * 48;
                float gl[4]; int gi = 0; float gm = -INFINITY;
#pragma unroll
                for (int j = 0; j < 4; ++j) { gl[j] = lg[j] * rstd + KA->b_group[j]; if (gl[j] > gm) { gm = gl[j]; gi = j; } }
                float gden = 0.f;
#pragma unroll
                for (int j = 0; j < 4; ++j) gden += expf(gl[j] - gm);
                const float gtop = 1.0f / gden;
                float el[8]; int e1 = 0; float m1 = -INFINITY;
#pragma unroll
                for (int j = 0; j < 8; ++j) { el[j] = lg[4 + gi * 8 + j] * rstd + KA->b_router[gi * 8 + j]; if (el[j] > m1) { m1 = el[j]; e1 = j; } }
                int e2 = 0; float m2 = -INFINITY;
#pragma unroll
                for (int j = 0; j < 8; ++j) if (j != e1 && el[j] > m2) { m2 = el[j]; e2 = j; }
                const float q2 = expf(m2 - m1), inv = gtop / (1.0f + q2);
                w1v = inv; w2v = q2 * inv;
                l1 = gi * 8 + e1; l2 = 32 + gi * 8 + e2; my_m = m;
                r1 = __hip_atomic_fetch_add(hist + l1, 1, __ATOMIC_RELAXED, __HIP_MEMORY_SCOPE_WORKGROUP);
                r2 = __hip_atomic_fetch_add(hist + l2, 1, __ATOMIC_RELAXED, __HIP_MEMORY_SCOPE_WORKGROUP);
            }
            __syncthreads();
            if (tid < 64) { const int n = hist[tid]; hist[64 + tid] = n ? (int)__hip_atomic_fetch_add(ctl + CW_CNT + tid, (unsigned)n, __ATOMIC_RELAXED, __HIP_MEMORY_SCOPE_AGENT) : 0; }
            __syncthreads();
            if (lane < 16 && my_m >= 0) {
                const int p1 = l1 * LCAP + hist[64 + l1] + r1, p2 = l2 * LCAP + hist[64 + l2] + r2;
                TOK[p1] = my_m; RS[p1] = rstd; CWt[p1] = w1v; TOK[p2] = my_m; RS[p2] = rstd; CWt[p2] = w2v;
            }
            __syncthreads();
            if (tid < 64) hist[tid] = 0;
            __syncthreads();
        }
    }
    GRID_BAR();
    STAMP(6);

    if (PH(6)) {
        const KArgsP KA = kargs();
        LAS int* pre = (LAS int*)(L + LDSX_OFF + 1024);
        LAS int* cntl = (LAS int*)(L + LDSX_OFF + 2048);
        if (tid < 64) cntl[tid] = (int)__hip_atomic_load(ctl + CW_CNT + tid, __ATOMIC_RELAXED, __HIP_MEMORY_SCOPE_AGENT);
        __syncthreads();
        if (tid == 0) { int run = 0; for (int l = 0; l < 64; ++l) { pre[l] = run; run += (cntl[l] + 255) >> 8; } pre[64] = run; }
        __syncthreads();
        if (PH(7)) { MoeOrder<2, true> S{pre, cntl, 0, 64, G, vcu, (const char*)H1B8, (const char*)W13, TOK, 0, 2 * G}; EpiSwiGLU E{HH, RS, CWt};
          pg8::gemm_phase<EpiSwiGLU, MoeOrder<2, true>, true, false, false, true>(L, 512, S, E, wave); }
        GRID_BAR();
        STAMP(7);
        if (PH(7)) { MoeOrder<2, true> S{pre, cntl, 0, 64, G, vcu, (const char*)H1B8, (const char*)W13, TOK, 2 * G, -1}; EpiSwiGLU E{HH, RS, CWt};
          pg8::gemm_phase<EpiSwiGLU, MoeOrder<2, true>, true, false, false, true>(L, 512, S, E, wave); }
        const int nleft = max(0, 2 * (int)pre[64] - 2 * G), nb = min(nleft, G / 2), v_ = vcu; const bool lo_ = v_ < nb;
        if (PH(8)) { MoeOrder<4, false, 1> S{pre, cntl, 0, 32, lo_ ? G : G - nb, lo_ ? v_ : v_, (const char*)HH, (const char*)W2t, TOK, 0, lo_ ? nb : -1}; EpiScatter<false> E{H1B, KA->out, TOK};
          pg8::gemm_phase<EpiScatter<false>, MoeOrder<4, false, 1>, false, false, false, true>(L, 128, S, E, wave); }
        GRID_BAR();
        STAMP(8);
        if (PH(9)) { MoeOrder<4, false, 1> S{pre, cntl, 32, 32, G, vcu, (const char*)HH, (const char*)W2t, TOK, 0, -1}; EpiScatter<true> E{H1B, KA->out, TOK};
          pg8::gemm_phase<EpiScatter<true>, MoeOrder<4, false, 1>, false, false, false, true>(L, 128, S, E, wave); }
    }
    if (PROBE_PHASE >= 0) { GRID_BAR(); STAMP(9); const KArgsP KA = kargs();
        if (bx == 0 && wave == 0 && lane_id() == 0) { volatile LAS unsigned long long* st = (volatile LAS unsigned long long*)(L + LDSX_OFF + 4096); const float us = (PROBE_PHASE == 14) ? (float)st[32] * 0.01f : (float)(st[PROBE_PHASE + 1] - st[PROBE_PHASE]) * 0.01f; KA->out[0] += us * 0.1f; } }
#undef tid
#undef lane
#undef G
#undef bx
#undef vcu
#undef gw
#undef NGW
}
#undef ctl
#undef Wmain
#undef Wg8
#undef HN8
#undef H1B8
#undef Wa
#undef We
#undef Wout
#undef Wr
#undef HNM
#undef LF
#undef SSQ
#undef RINV
#undef W13
#undef W2t
#undef TOK
#undef RS
#undef CWt
#undef HN
#undef YP
#undef H1B
#undef Gt
#undef HH
#undef Qb
#undef Kb
#undef Vb
#undef Ub
#undef MG
#undef Ob
#undef MIX

extern "C" void kernel_launch(void* const* d_in, const int* in_sizes, int n_in, void* d_out, int out_size, void* d_ws, size_t ws_size, hipStream_t stream) {
    static int grid = 0;
    if (grid == 0) {
        if (n_in != 20 || in_sizes[0] != MX * DM_ || out_size != MX * DM_ || ws_size < WS_END) { fprintf(stderr, "kernel_launch: unexpected shapes (n_in %d, in0 %d, out %d, ws %zu)\n", n_in, n_in > 0 ? in_sizes[0] : -1, out_size, ws_size); grid = -1; return; }
        int dev = 0, cus = 0, per_cu = 0;
        if (hipGetDevice(&dev) != hipSuccess || hipDeviceGetAttribute(&cus, hipDeviceAttributeMultiprocessorCount, dev) != hipSuccess) { grid = -1; return; }
        if (hipFuncSetAttribute((const void*)fwd_megakernel, hipFuncAttributeMaxDynamicSharedMemorySize, LDS_BYTES) != hipSuccess) { fprintf(stderr, "kernel_launch: hipFuncSetAttribute failed\n"); grid = -1; return; }
        if (hipOccupancyMaxActiveBlocksPerMultiprocessor(&per_cu, (const void*)fwd_megakernel, 512, LDS_BYTES) != hipSuccess || per_cu < 1) { fprintf(stderr, "kernel_launch: occupancy query says %d\n", per_cu); (void)hipGetLastError(); grid = -1; return; }
        grid = cus;
        if (grid != 256) fprintf(stderr, "kernel_launch: %d CUs (built for 256)\n", grid);
    }
    if (grid < 0) return;
    (void)hipMemsetAsync((char*)d_ws + WS_CTL, 0, CTL_BYTES, stream);
    Args a{};
    a.x = (const float*)d_in[0]; a.meta = (const float*)d_in[1]; a.g_mix = (const float*)d_in[2]; a.w_in = (const float*)d_in[3]; a.b_forget = (const float*)d_in[4];
    a.gq = (const float*)d_in[5]; a.gk = (const float*)d_in[6]; a.w_up_attn = (const float*)d_in[7]; a.w_pool = (const float*)d_in[8]; a.pool_scale = (const float*)d_in[9];
    a.w_up_pool = (const float*)d_in[10]; a.w_out = (const float*)d_in[11]; a.g_ffn = (const float*)d_in[12]; a.w_group = (const float*)d_in[13]; a.b_group = (const float*)d_in[14];
    a.w_router = (const float*)d_in[15]; a.b_router = (const float*)d_in[16]; a.w1 = (const float*)d_in[17]; a.w3 = (const float*)d_in[18]; a.w2 = (const float*)d_in[19];
    a.out = (float*)d_out; a.ws = (unsigned char*)d_ws;
    void* kargs[] = {&a};
    hipError_t e = hipLaunchCooperativeKernel((void*)fwd_megakernel, dim3(grid), dim3(512), kargs, LDS_BYTES, stream);
    if (e != hipSuccess) fprintf(stderr, "cooperative launch failed: %s (grid %d)\n", hipGetErrorString(e), grid);
}
```

```cpp
#include <hip/hip_runtime.h>
#include <hip/hip_cooperative_groups.h>
#include <hip/hip_bf16.h>
#include <cstdio>
#include <cstdint>
#include <cmath>
namespace cg = cooperative_groups;

constexpr int DM_ = 1024, NBATCH = 8, SEQ_ = 4096, MX = NBATCH * SEQ_;
constexpr int NMETA = 16, LP = 4160, KVR = NBATCH * LP;
constexpr int NHEAD_ = 8, HD_ = 64, AW = 512, PW = 512, NMAIN = 4096;
constexpr int NEXP = 32, FH = 256, LCAP = 32768;
constexpr float RMS_EPS = 1e-6f;
constexpr float LOG2E = 1.4426950408889634f;
constexpr float C2 = 0.125f * LOG2E;

constexpr size_t MiB = 1u << 20;
constexpr size_t WS_CTL = 0, CTL_BYTES = 65536;
constexpr size_t WS_WMAIN = 2 * MiB, WS_WA = 10 * MiB, WS_WE = 11 * MiB, WS_WOUT = 12 * MiB, WS_WR = 14 * MiB, WS_HNM = 15 * MiB;
constexpr size_t WS_RINV = 15 * MiB + 512 * 1024;
constexpr size_t WS_LF = 16 * MiB, WS_SSQ = 18 * MiB, WS_W13 = 20 * MiB, WS_W2 = 52 * MiB;
constexpr size_t WS_TOK = 68 * MiB, WS_RS = 76 * MiB, WS_CW = 84 * MiB;
constexpr size_t WS_RA = 96 * MiB;
constexpr size_t WS_RB = 160 * MiB;
constexpr size_t WS_Q = 288 * MiB, WS_K = 320 * MiB, WS_V = 353 * MiB, WS_U = 386 * MiB;
constexpr size_t WS_MG = 288 * MiB;
constexpr size_t WS_HN8 = 224 * MiB;
constexpr size_t WS_H1B8 = 353 * MiB;
constexpr size_t WS_WG8 = 6 * MiB;
constexpr size_t WS_O = 420 * MiB, WS_MIX = 452 * MiB, WS_END = 484 * MiB;
constexpr int CW_CNT = 0, CW_XBAR = 4096;

#ifndef PH_MASK
#define PH_MASK 0xffff
#endif
#define PH(k) ((PH_MASK >> (k)) & 1)
#ifndef PROBE_PHASE
#define PROBE_PHASE -1
#endif
constexpr int RING_BYTES = 131072, LDSX_OFF = RING_BYTES, LDS_BYTES = 147456;

#define LAS __attribute__((address_space(3)))
typedef unsigned short bf16_t;
typedef short bf16x8 __attribute__((ext_vector_type(8)));
typedef float f32x4 __attribute__((ext_vector_type(4)));
typedef float f32x2 __attribute__((ext_vector_type(2)));
typedef unsigned u32x4 __attribute__((ext_vector_type(4)));
typedef unsigned u32x2 __attribute__((ext_vector_type(2)));

typedef __bf16 bf16x2_v __attribute__((ext_vector_type(2)));
__device__ __forceinline__ unsigned cvt_pk_bf16(float lo, float hi) { f32x2 v = {lo, hi}; bf16x2_v b = __builtin_convertvector(v, bf16x2_v); return __builtin_bit_cast(unsigned, b); }
__device__ __forceinline__ float bf_lo(unsigned w) { return __uint_as_float(w << 16); }
__device__ __forceinline__ float bf_hi(unsigned w) { return __uint_as_float(w & 0xffff0000u); }
__device__ __forceinline__ float fast_sigmoid(float x) { return __builtin_amdgcn_rcpf(1.0f + __builtin_amdgcn_exp2f(-x * LOG2E)); }
__device__ __forceinline__ int lane_id();
__device__ __forceinline__ float shfl_xor_local(float v, int mask);
__device__ __forceinline__ int lane_id() { unsigned z = 0u; asm volatile("" : "+v"(z)); return (int)__builtin_amdgcn_mbcnt_hi(~0u, __builtin_amdgcn_mbcnt_lo(~0u, z)); }
__device__ __forceinline__ float shfl_xor_local(float v, int mask) { return __builtin_bit_cast(float, __builtin_amdgcn_ds_bpermute((lane_id() ^ mask) << 2, __builtin_bit_cast(int, v))); }
__device__ __forceinline__ u32x4 widen16(u32x2 a, u32x2 b) {
    const auto rx = __builtin_amdgcn_permlane16_swap(a.x, b.x, false, false), ry = __builtin_amdgcn_permlane16_swap(a.y, b.y, false, false);
    return (u32x4){rx[0], ry[0], rx[1], ry[1]};
}
__device__ __forceinline__ float wave_sum(float v) {
#pragma unroll
    for (int o = 1; o < 64; o <<= 1) v += __shfl_xor(v, o);
    return v;
}

namespace pg8 {
constexpr int BM = 256, BK = 64, HALF = 128, HTB = HALF * BK * 2, NXCD = 8, WGM = 4;
__host__ __device__ __forceinline__ int lds_byte(int r, int c) { const int st = (r >> 4) * 2 + (c >> 5), rr = r & 15, cc = c & 31, ob = rr * 64 + cc * 2; return st * 1024 + (ob ^ (((ob >> 9) & 1) << 5)); }
__host__ __device__ __forceinline__ void stage_rc(int b, int& R, int& C) { const int st = b / 1024, sb = b % 1024, swz = sb ^ (((sb >> 9) & 1) << 5); R = (st >> 1) * 16 + swz / 64; C = (st & 1) * 32 + (swz % 64) / 2; }
__host__ __device__ __forceinline__ int perm32(int rho) { const int n = rho >> 4, i = rho & 15; return 8 * (i >> 2) + 4 * n + (i & 3); }

struct Unit { const char* a; const char* b; const int* tok; int pm, pn, cnt, aux, hrow; };

struct GridOrder {
    int nM, nN, nwg, G, c; const char* A; const char* B; size_t tsA, tsB;
    __device__ void init(const void* A_, const void* B_, int M, int N, int K, int G_, int c_) { nM = M / BM; nN = N / BM; nwg = nM * nN; G = G_; c = c_; A = (const char*)A_; B = (const char*)B_; tsA = (size_t)BM * K * 2; tsB = tsA; }
    __device__ bool next(int i, Unit& u) const {
        const long L = (long)i * G + c; if (L >= nwg) return false;
        int wgid = (int)L; { const int q = nwg / NXCD, r = nwg % NXCD, xcd = wgid % NXCD, off = wgid / NXCD; wgid = (xcd < r ? xcd * (q + 1) : r * (q + 1) + (xcd - r) * q) + off; }
        const int nig = WGM * nN, gid = wgid / nig, fm = gid * WGM, gsz = (nM - fm) < WGM ? (nM - fm) : WGM;
        u.pm = fm + ((wgid % nig) % gsz); u.pn = (wgid % nig) / gsz; u.a = A + (size_t)u.pm * tsA; u.b = B + (size_t)u.pn * tsB; u.tok = nullptr; u.cnt = 256; u.aux = 0; u.hrow = 0; return true;
    }
};

typedef int pg8_v4i __attribute__((ext_vector_type(4)));
typedef int pg8_v8i __attribute__((ext_vector_type(8)));
__device__ __forceinline__ pg8_v8i pg8_cat(bf16x8 lo, bf16x8 hi) { const pg8_v4i a = __builtin_bit_cast(pg8_v4i, lo), b = __builtin_bit_cast(pg8_v4i, hi); return __builtin_shufflevector(a, b, 0, 1, 2, 3, 4, 5, 6, 7); }
template <class Epi, class Sched, bool GATHER, bool HOOK = false, bool TPROBE = false, bool FP8 = false, int MIX8 = 0>
__device__ __forceinline__ void gemm_phase(LAS unsigned char* lds, const int K, const Sched& S, const Epi& E, const int wave_s) {
    int tid_ = wave_s * 64 + lane_id(); asm volatile("" : "+v"(tid_));
    const int tid = tid_, wid = wave_s, lane = tid & 63, wr = wid >> 2, wc = wid & 3, fr = lane & 15, fq = lane >> 4;
    const int nt = K / BK;
    int Rr[2], Cc[2]; unsigned voffB[2];
#pragma unroll
    for (int i = 0; i < 2; ++i) { stage_rc(tid * 16 + i * 8192, Rr[i], Cc[i]); const int Rb = (Rr[i] & ~31) + perm32(Rr[i] & 31); voffB[i] = (unsigned)(Rb * K + Cc[i]) * 2u; }
    const size_t kstep = (size_t)(BK * 2);
    const size_t hstep = (size_t)HALF * K * 2;
    const unsigned ldsw = (unsigned)wid * 1024u;
    const int aoff = lds_byte(wr * 64 + fr, fq * 8), boff = lds_byte(wc * 32 + fr, fq * 8);
#define PG8_SA(b, h) (((b) * 2 + (h)) * HTB)
#define PG8_SB(b, h) ((4 + (b) * 2 + (h)) * HTB)
#define PG8_STAGE(bufoff, gbase, voff) do { _Pragma("unroll") for (int _i = 0; _i < 2; ++_i) \
        __builtin_amdgcn_global_load_lds((const unsigned*)((const char*)(gbase) + (voff)[_i]), (LAS unsigned*)(lds + (bufoff) + ldsw + _i * 8192), 16, 0, 0); } while (0)
#define PG8_LD8(dstv, off) do { const pg8_v4i _lo = *(const LAS pg8_v4i*)(lds + (off)), _hi = *(const LAS pg8_v4i*)(lds + (off) + 1024); dstv = __builtin_shufflevector(_lo, _hi, 0, 1, 2, 3, 4, 5, 6, 7); } while (0)
#define PG8_LDA(dst, b, h) do { if constexpr (F8_ || MIX8 > 0) { _Pragma("unroll") for (int m = 0; m < 4; ++m) PG8_LD8(At8[m], PG8_SA(b, h) + aoff + m * 2048); } else PG8_LDA_(dst, b, h); } while (0)
#define PG8_LDB(dst, b, h) do { if constexpr (F8_ || MIX8 > 0) { _Pragma("unroll") for (int n = 0; n < 2; ++n) PG8_LD8(dst##8[n], PG8_SB(b, h) + boff + n * 2048); } else PG8_LDB_(dst, b, h); } while (0)
#define PG8_LDA_(dst, b, h) do { _Pragma("unroll") for (int m = 0; m < 4; ++m) _Pragma("unroll") for (int k = 0; k < 2; ++k) dst[m][k] = *(const LAS bf16x8*)(lds + PG8_SA(b, h) + aoff + m * 2048 + k * 1024); } while (0)
#define PG8_LDB_(dst, b, h) do { _Pragma("unroll") for (int n = 0; n < 2; ++n) _Pragma("unroll") for (int k = 0; k < 2; ++k) dst[n][k] = *(const LAS bf16x8*)(lds + PG8_SB(b, h) + boff + n * 2048 + k * 1024); } while (0)
#define PG8_MMA(ai, bj, At, Bt) do { if constexpr (F8_) __builtin_amdgcn_sched_barrier(0); __builtin_amdgcn_s_setprio(1); _Pragma("unroll") for (int m = 0; m < 4; ++m) _Pragma("unroll") for (int n = 0; n < 2; ++n) { \
        if constexpr (F8_) { asm volatile("v_mfma_scale_f32_16x16x128_f8f6f4 %0, %1, %2, %0, %3, %3 op_sel_hi:[0,0,0]" : "+v"(acc[ai][bj][m][n]) : "v"(Bt##8[n]), "v"(At##8[m]), "v"(sc8)); } \
        else if constexpr (MIX8 > 0) {     \
            acc[ai][bj][m][n] = __builtin_amdgcn_mfma_f32_16x16x32_bf16(PG8_LO(Bt##8[n]), PG8_LO(At##8[m]), acc[ai][bj][m][n], 0, 0, 0); \
            acc[ai][bj][m][n] = __builtin_amdgcn_mfma_f32_16x16x32_bf16(PG8_HI(Bt##8[n]), PG8_HI(At##8[m]), acc[ai][bj][m][n], 0, 0, 0); } \
        else { _Pragma("unroll") for (int k = 0; k < 2; ++k) acc[ai][bj][m][n] = __builtin_amdgcn_mfma_f32_16x16x32_bf16(Bt[n][k], At[m][k], acc[ai][bj][m][n], 0, 0, 0); } } \
        __builtin_amdgcn_s_setprio(0); if constexpr (F8_) __builtin_amdgcn_sched_barrier(0); } while (0)
#define PG8_LO(v) __builtin_bit_cast(bf16x8, __builtin_shufflevector(v, v, 0, 1, 2, 3))
#define PG8_HI(v) __builtin_bit_cast(bf16x8, __builtin_shufflevector(v, v, 4, 5, 6, 7))
#define PG8_WAIT_V(n) asm volatile("s_waitcnt vmcnt(" #n ")" ::: "memory")
#define PG8_WAIT_L(n) asm volatile("s_waitcnt lgkmcnt(" #n ")" ::: "memory")
#define PG8_BAR __builtin_amdgcn_s_barrier()
#define PG8_SCHED __builtin_amdgcn_sched_barrier(0)
#define PG8_SETA(v, u) do { _Pragma("unroll") for (int _h = 0; _h < 2; ++_h) _Pragma("unroll") for (int _i = 0; _i < 2; ++_i) { const int _row = Rr[_i] + 128 * _h; \
        int _t = _row; if (GATHER) { _t = (_row < (u).cnt) ? (u).tok[_row] : 0; } v[_h][_i] = (unsigned)(_t * K + Cc[_i]) * 2u; } } while (0)
#define PG8_ITER_BODY \
            PG8_LDB(B0, 0, 0); PG8_LDB(B1, 0, 1); PG8_SCHED; PG8_LDA(At, 0, 0); PG8_STAGE(PG8_SA(1, 1), a1, cvA[1]); \
            PG8_WAIT_V(8); PG8_WAIT_L(0); PG8_BAR; PG8_MMA(0, 0, At, B0); PG8_MMA(0, 1, At, B1); PG8_BAR; PG8_SCHED; \
            PG8_LDA(At, 0, 1); PG8_STAGE(PG8_SB(0, 0), b2, voffB); PG8_STAGE(PG8_SB(0, 1), b2 + hstep, voffB); PG8_STAGE(PG8_SA(0, 0), a2, xv[0]); \
            PG8_WAIT_V(8); PG8_WAIT_L(0); PG8_BAR; PG8_MMA(1, 0, At, B0); PG8_MMA(1, 1, At, B1); PG8_BAR; PG8_SCHED; \
            PG8_LDB(B0, 1, 0); PG8_LDB(B1, 1, 1); PG8_SCHED; PG8_LDA(At, 1, 0); PG8_STAGE(PG8_SA(0, 1), a2, xv[1]); \
            PG8_WAIT_V(8); PG8_WAIT_L(0); PG8_BAR; PG8_MMA(0, 0, At, B0); PG8_MMA(0, 1, At, B1); PG8_BAR; PG8_SCHED; \
            PG8_LDA(At, 1, 1); PG8_STAGE(PG8_SB(1, 0), b3, voffB); PG8_STAGE(PG8_SB(1, 1), b3 + hstep, voffB); PG8_STAGE(PG8_SA(1, 0), a3, xv[0]); \
            PG8_WAIT_V(8); PG8_WAIT_L(0); PG8_BAR; PG8_MMA(1, 0, At, B0); PG8_MMA(1, 1, At, B1); PG8_BAR; PG8_SCHED;
    Unit cur, nxt; int ui = 0;
    if (!S.next(0, cur)) return;
    f32x4 acc[2][2][4][2];
#pragma unroll
    for (int a = 0; a < 2; ++a)
#pragma unroll
        for (int b = 0; b < 2; ++b)
#pragma unroll
            for (int m = 0; m < 4; ++m)
#pragma unroll
                for (int n = 0; n < 2; ++n) acc[a][b][m][n] = (f32x4){0.f, 0.f, 0.f, 0.f};
    bf16x8 At[4][2], B0[2][2], B1[2][2];
    unsigned sc8 = 0x7F7F7F7Fu; asm volatile("" : "+v"(sc8));
    pg8_v8i At8[4], B08[2], B18[2];
    unsigned cvA[2][2], nvA[2][2];
    PG8_SETA(cvA, cur);
    const char* cA = cur.a; const char* cB = cur.b;
    PG8_STAGE(PG8_SB(0, 0), cB, voffB); PG8_STAGE(PG8_SB(0, 1), cB + hstep, voffB); PG8_STAGE(PG8_SA(0, 0), cA, cvA[0]); PG8_STAGE(PG8_SA(0, 1), cA, cvA[1]);
    if (wr == 1) PG8_BAR;
    PG8_WAIT_V(2); PG8_BAR;
    PG8_STAGE(PG8_SB(1, 0), cB + kstep, voffB); PG8_STAGE(PG8_SA(1, 0), cA + kstep, cvA[0]); PG8_STAGE(PG8_SB(1, 1), cB + hstep + kstep, voffB);
    PG8_WAIT_V(6); PG8_BAR;
    for (;;) {
        const bool has_next = S.next(ui + 1, nxt);
        if (has_next) { PG8_SETA(nvA, nxt); } else {
#pragma unroll
            for (int h = 0; h < 2; ++h)
#pragma unroll
                for (int i = 0; i < 2; ++i) nvA[h][i] = cvA[h][i]; }
        const char* nA = has_next ? nxt.a : cA; const char* nB = has_next ? nxt.b : cB;
        unsigned long long tk0_ = 0; if constexpr (TPROBE) tk0_ = __builtin_amdgcn_s_memrealtime();
#define PG8_ITER_SETUP \
            const bool last = (t == nt - 2); \
            const char* a1 = cA + (size_t)(t + 1) * kstep; \
            const char* a2 = last ? nA : cA + (size_t)(t + 2) * kstep; const char* b2 = last ? nB : cB + (size_t)(t + 2) * kstep; \
            const char* a3 = a2 + kstep; const char* b3 = b2 + kstep; \
            unsigned xv[2][2]; \
            _Pragma("unroll") for (int h = 0; h < 2; ++h) _Pragma("unroll") for (int i = 0; i < 2; ++i) xv[h][i] = last ? nvA[h][i] : cvA[h][i];
        if constexpr (MIX8 > 0) {
            _Pragma("unroll 1") for (int t = 0; t < MIX8; t += 2) { PG8_ITER_SETUP constexpr bool F8_ = true; PG8_ITER_BODY }
            asm volatile("s_nop 15\n\ts_nop 15" ::: "memory");
            if constexpr (HOOK) E.mid(acc, cur, wr, wc, fr, fq);
            _Pragma("unroll 1") for (int t = MIX8; t < nt; t += 2) { PG8_ITER_SETUP constexpr bool F8_ = false; PG8_ITER_BODY }
        } else {
        for (int t = 0; t < nt; t += 2) {
            const bool last = (t == nt - 2);
            if constexpr (HOOK) { if (t == (nt >> 1)) E.mid(acc, cur, wr, wc, fr, fq); }
            const char* a1 = cA + (size_t)(t + 1) * kstep;
            const char* a2 = last ? nA : cA + (size_t)(t + 2) * kstep; const char* b2 = last ? nB : cB + (size_t)(t + 2) * kstep;
            const char* a3 = a2 + kstep; const char* b3 = b2 + kstep;
            unsigned xv[2][2];
#pragma unroll
            for (int h = 0; h < 2; ++h)
#pragma unroll
                for (int i = 0; i < 2; ++i) xv[h][i] = last ? nvA[h][i] : cvA[h][i];
            constexpr bool F8_ = FP8; PG8_ITER_BODY
        }
        }
#undef PG8_ITER_SETUP
        if constexpr (TPROBE) { if (blockIdx.x == 0 && tid == 0) { volatile LAS unsigned long long* st_ = (volatile LAS unsigned long long*)(lds + 131072 + 4096 + 256); st_[0] = st_[0] + (__builtin_amdgcn_s_memrealtime() - tk0_); } }
        if constexpr (FP8) asm volatile("s_nop 15\n\ts_nop 15" ::: "memory");
        if (wr == 0) PG8_BAR;
        E(acc, cur, wr, wc, fr, fq);
        if (!has_next) break;
#pragma unroll
        for (int a = 0; a < 2; ++a)
#pragma unroll
            for (int b = 0; b < 2; ++b)
#pragma unroll
                for (int m = 0; m < 4; ++m)
#pragma unroll
                    for (int n = 0; n < 2; ++n) acc[a][b][m][n] = (f32x4){0.f, 0.f, 0.f, 0.f};
        cur = nxt; cA = nA; cB = nB; ++ui;
#pragma unroll
        for (int h = 0; h < 2; ++h)
#pragma unroll
            for (int i = 0; i < 2; ++i) cvA[h][i] = nvA[h][i];
        if (wr == 1) PG8_BAR;
    }
    PG8_WAIT_V(0);
    PG8_BAR;
#undef PG8_SA
#undef PG8_SB
#undef PG8_STAGE
#undef PG8_LDA
#undef PG8_LDA_
#undef PG8_LDB_
#undef PG8_LD8
#undef PG8_LDB
#undef PG8_ITER_BODY
#undef PG8_MMA
#undef PG8_WAIT_V
#undef PG8_WAIT_L
#undef PG8_BAR
#undef PG8_SCHED
#undef PG8_SETA
}
}

typedef f32x4 AccT[2][2][4][2];

struct EpiInProj {
    bf16_t *Q, *Kp, *Vp, *Up, *G; const float *gq, *gk; float eps; int pn0;
    __device__ __forceinline__ void operator()(const AccT& acc, const pg8::Unit& u, int wr, int wc, int fr, int fq) const {
        const int pn = u.pn + pn0, pm = u.pm, b = pm >> 4;
        const int row0 = pm * 256 + wr * 64 + fr, prow0 = row0 + 64 * (b + 1);
        const int d0 = 8 * fq;
        if (pn < 4) {
            const bool isq = pn < 2; const float* gv = isq ? gq : gk; const float sc = isq ? LOG2E : 1.0f;
            float g0[8], g1[8];
#pragma unroll
            for (int i = 0; i < 8; ++i) { g0[i] = gv[d0 + i] * sc; g1[i] = gv[32 + d0 + i] * sc; }
            unsigned char* base = (unsigned char*)(isq ? Q : Kp) + (size_t)(isq ? row0 : prow0) * 1024 + 128 * (4 * (pn & 1) + wc) + 16 * (fq >> 1);
#pragma unroll
            for (int ai = 0; ai < 2; ++ai)
#pragma unroll
                for (int mp = 0; mp < 2; ++mp) { u32x2 w0[2], w1[2];
#pragma unroll
                    for (int mm = 0; mm < 2; ++mm) { const int m = 2 * mp + mm;
                        const f32x4 v00 = acc[ai][0][m][0], v01 = acc[ai][0][m][1], v10 = acc[ai][1][m][0], v11 = acc[ai][1][m][1];
                        float ss = 0.f;
#pragma unroll
                        for (int i = 0; i < 4; ++i) ss += v00[i] * v00[i] + v01[i] * v01[i] + v10[i] * v10[i] + v11[i] * v11[i];
                        ss += shfl_xor_local(ss, 16); ss += shfl_xor_local(ss, 32);
                        const float r = __builtin_amdgcn_rsqf(ss * (1.0f / 64.0f) + eps);
                        u32x2 a = {0u, 0u}, b = {0u, 0u};
                        a.x = __builtin_amdgcn_cvt_pk_fp8_f32(v00[0] * r * g0[0], v00[1] * r * g0[1], a.x, false); a.x = __builtin_amdgcn_cvt_pk_fp8_f32(v00[2] * r * g0[2], v00[3] * r * g0[3], a.x, true);
                        a.y = __builtin_amdgcn_cvt_pk_fp8_f32(v01[0] * r * g0[4], v01[1] * r * g0[5], a.y, false); a.y = __builtin_amdgcn_cvt_pk_fp8_f32(v01[2] * r * g0[6], v01[3] * r * g0[7], a.y, true);
                        b.x = __builtin_amdgcn_cvt_pk_fp8_f32(v10[0] * r * g1[0], v10[1] * r * g1[1], b.x, false); b.x = __builtin_amdgcn_cvt_pk_fp8_f32(v10[2] * r * g1[2], v10[3] * r * g1[3], b.x, true);
                        b.y = __builtin_amdgcn_cvt_pk_fp8_f32(v11[0] * r * g1[4], v11[1] * r * g1[5], b.y, false); b.y = __builtin_amdgcn_cvt_pk_fp8_f32(v11[2] * r * g1[6], v11[3] * r * g1[7], b.y, true);
                        w0[mm] = a; w1[mm] = b; }
                    unsigned char* rowp = base + (size_t)(ai * 128 + (2 * mp + (fq & 1)) * 16) * 1024;
                    *(u32x4*)(rowp) = widen16(w0[0], w0[1]); *(u32x4*)(rowp + 32) = widen16(w1[0], w1[1]);
                }
        } else if (pn < 8) {
            bf16_t* base = (pn < 6 ? Vp : Up) + (size_t)prow0 * 512 + 64 * (4 * (pn & 1) + wc) + d0;
#pragma unroll
            for (int ai = 0; ai < 2; ++ai)
#pragma unroll
                for (int m = 0; m < 4; ++m) { bf16_t* rowp = base + (size_t)(ai * 128 + m * 16) * 512;
#pragma unroll
                    for (int bj = 0; bj < 2; ++bj) { const f32x4 v0 = acc[ai][bj][m][0], v1 = acc[ai][bj][m][1]; u32x4 w;
                        w.x = cvt_pk_bf16(v0[0], v0[1]); w.y = cvt_pk_bf16(v0[2], v0[3]); w.z = cvt_pk_bf16(v1[0], v1[1]); w.w = cvt_pk_bf16(v1[2], v1[3]);
                        __builtin_nontemporal_store(w, (u32x4*)(rowp + 32 * bj)); } }
        }
    }
};
struct EpiGates8 {
    unsigned char* ws;
    __device__ __forceinline__ void operator()(const AccT& acc, const pg8::Unit& u, int wr, int wc, int fr, int fq) const {
        unsigned char* const G = ws + WS_RB; bf16_t* const Vp = (bf16_t*)(ws + WS_V);
        if (u.pn >= 8) {
            const int pv = u.pn - 8, b = u.pm >> 4, prow0 = u.pm * 256 + wr * 64 + fr + 64 * (b + 1);
            bf16_t* base = Vp + (size_t)prow0 * 512 + 64 * (4 * pv + wc) + 8 * fq;
#pragma unroll
            for (int ai = 0; ai < 2; ++ai)
#pragma unroll
                for (int m = 0; m < 4; ++m) { bf16_t* rowp = base + (size_t)(ai * 128 + m * 16) * 512;
#pragma unroll
                    for (int bj = 0; bj < 2; ++bj) { const f32x4 v0 = acc[ai][bj][m][0] * (1.0f / 32.0f), v1 = acc[ai][bj][m][1] * (1.0f / 32.0f); u32x4 w;
                        w.x = cvt_pk_bf16(v0[0], v0[1]); w.y = cvt_pk_bf16(v0[2], v0[3]); w.z = cvt_pk_bf16(v1[0], v1[1]); w.w = cvt_pk_bf16(v1[2], v1[3]);
                        __builtin_nontemporal_store(w, (u32x4*)(rowp + 32 * bj)); } }
            return;
        }
        unsigned char* base0 = G + (size_t)(u.pm * 262144 + (u.pn >> 1) * 65536 + (u.pn & 1) * 16384 + wr * 4096 + wc * 1024 + (fr + 16 * fq) * 16); unsigned char* base1 = base0 + (size_t)MX * 1024;
#pragma unroll
        for (int ai = 0; ai < 2; ++ai)
#pragma unroll
            for (int mp = 0; mp < 2; ++mp) { const size_t ro = (size_t)(ai * 32768 + mp * 8192); u32x4 w0, w1;
#pragma unroll
                for (int mm = 0; mm < 2; ++mm) { const int m = 2 * mp + mm; unsigned q0[8], q1[8];
#pragma unroll
                    for (int n = 0; n < 2; ++n)
#pragma unroll
                        for (int i = 0; i < 4; ++i) { const float s0 = fast_sigmoid(acc[ai][0][m][n][i] * (1.0f / 32.0f)), s1 = fast_sigmoid(acc[ai][1][m][n][i] * (1.0f / 32.0f));
                            q0[4 * n + i] = (unsigned)(s0 * 255.0f + 0.5f); q1[4 * n + i] = max(1u, (unsigned)(s1 * 255.0f + 0.5f)); }
                    const unsigned a = q0[0] | (q0[1] << 8) | (q0[2] << 16) | (q0[3] << 24), b = q0[4] | (q0[5] << 8) | (q0[6] << 16) | (q0[7] << 24);
                    const unsigned c = q1[0] | (q1[1] << 8) | (q1[2] << 16) | (q1[3] << 24), d = q1[4] | (q1[5] << 8) | (q1[6] << 16) | (q1[7] << 24);
                    if (mm == 0) { w0.x = a; w0.y = b; w1.x = c; w1.y = d; } else { w0.z = a; w0.w = b; w1.z = c; w1.w = d; } }
                __builtin_nontemporal_store(w0, (u32x4*)(base0 + ro)); __builtin_nontemporal_store(w1, (u32x4*)(base1 + ro)); }
    }
};
constexpr float YA_SC = 1.0f / (32.0f * 4.0f);
constexpr float MG_SCALE = 8.0f;
struct EpiMerged {
    bf16_t* out; const unsigned char* g0q; const unsigned char* g1q;
    template <bool MID> __device__ __forceinline__ void apply(AccT& acc, const pg8::Unit& u, int wr, int wc, int fr, int fq) const {
        int row0 = u.pm * 256 + wr * 64 + fr, col0 = u.pn * 256 + wc * 32 + 8 * fq;
        int gbase = (u.pm * 4 + u.pn) * 65536 + wr * 4096 + wc * 1024 + (fr + 16 * fq) * 16;
        asm volatile("" : "+v"(row0), "+v"(col0), "+v"(gbase));
        if (MID) {
            u32x2 a1[2][2][4], a0[2][2][4];
#pragma unroll
            for (int ai = 0; ai < 2; ++ai)
#pragma unroll
                for (int bj = 0; bj < 2; ++bj)
#pragma unroll
                    for (int mp = 0; mp < 2; ++mp) { const size_t o = (size_t)(unsigned)(gbase + ai * 32768 + bj * 16384 + mp * 8192);
                        const u32x4 t1 = *(const u32x4*)(g1q + o), t0 = *(const u32x4*)(g0q + o);
                        a1[ai][bj][2 * mp] = (u32x2){t1.x, t1.y}; a1[ai][bj][2 * mp + 1] = (u32x2){t1.z, t1.w}; a0[ai][bj][2 * mp] = (u32x2){t0.x, t0.y}; a0[ai][bj][2 * mp + 1] = (u32x2){t0.z, t0.w}; }
#pragma unroll
            for (int ai = 0; ai < 2; ++ai)
#pragma unroll
                for (int bj = 0; bj < 2; ++bj)
#pragma unroll
                    for (int m = 0; m < 4; ++m) { f32x4 v0 = acc[ai][bj][m][0], v1 = acc[ai][bj][m][1];
#pragma unroll
                        for (int k = 0; k < 4; ++k) { const float d0 = (float)((a1[ai][bj][m].x >> (8 * k)) & 0xffu), d1 = (float)((a1[ai][bj][m].y >> (8 * k)) & 0xffu);
                            v0[k] *= (float)((a0[ai][bj][m].x >> (8 * k)) & 0xffu) * (__builtin_amdgcn_rcpf(d0) * YA_SC); v1[k] *= (float)((a0[ai][bj][m].y >> (8 * k)) & 0xffu) * (__builtin_amdgcn_rcpf(d1) * YA_SC); }
                        acc[ai][bj][m][0] = v0; acc[ai][bj][m][1] = v1; }
            asm volatile("" ::: "memory");
        } else {
            u32x2 a1[2][2][4];
#pragma unroll
            for (int ai = 0; ai < 2; ++ai)
#pragma unroll
                for (int bj = 0; bj < 2; ++bj)
#pragma unroll
                    for (int mp = 0; mp < 2; ++mp) { const u32x4 t1 = *(const u32x4*)(g1q + (size_t)(unsigned)(gbase + ai * 32768 + bj * 16384 + mp * 8192)); a1[ai][bj][2 * mp] = (u32x2){t1.x, t1.y}; a1[ai][bj][2 * mp + 1] = (u32x2){t1.z, t1.w}; }
#pragma unroll
            for (int ai = 0; ai < 2; ++ai)
#pragma unroll
                for (int bj = 0; bj < 2; ++bj)
#pragma unroll
                    for (int mp = 0; mp < 2; ++mp) { u32x2 w8p[2];
#pragma unroll
                      for (int mm = 0; mm < 2; ++mm) { const int m = 2 * mp + mm; f32x4 v0 = acc[ai][bj][m][0], v1 = acc[ai][bj][m][1]; const u32x2 g = a1[ai][bj][m];
#pragma unroll
                        for (int k = 0; k < 4; ++k) { v0[k] *= (float)((g.x >> (8 * k)) & 0xffu) * (1.0f / 255.0f); v1[k] *= (float)((g.y >> (8 * k)) & 0xffu) * (1.0f / 255.0f); }
                        if (u.pn < 2) { u32x2 w = {0u, 0u};
                            w.x = __builtin_amdgcn_cvt_pk_fp8_f32(v0[0] * MG_SCALE, v0[1] * MG_SCALE, w.x, false); w.x = __builtin_amdgcn_cvt_pk_fp8_f32(v0[2] * MG_SCALE, v0[3] * MG_SCALE, w.x, true);
                            w.y = __builtin_amdgcn_cvt_pk_fp8_f32(v1[0] * MG_SCALE, v1[1] * MG_SCALE, w.y, false); w.y = __builtin_amdgcn_cvt_pk_fp8_f32(v1[2] * MG_SCALE, v1[3] * MG_SCALE, w.y, true);
                            w8p[mm] = w; }
                        else { unsigned char* const rp = (unsigned char*)out + (size_t)(row0 + ai * 128 + m * 16) * 1536;
                            u32x4 w; w.x = cvt_pk_bf16(v0[0], v0[1]); w.y = cvt_pk_bf16(v0[2], v0[3]); w.z = cvt_pk_bf16(v1[0], v1[1]); w.w = cvt_pk_bf16(v1[2], v1[3]);
                            *(u32x4*)(rp + 512 + (col0 + bj * 128 - 512) * 2) = w; } }
                      if (u.pn < 2) {
                          unsigned char* const rp = (unsigned char*)out + (size_t)(row0 + ai * 128 + (2 * mp + (fq & 1)) * 16) * 1536;
                          *(u32x4*)(rp + (col0 - 8 * fq) + 16 * (fq >> 1) + bj * 128) = widen16(w8p[0], w8p[1]); } }
        }
    }
    __device__ __forceinline__ void mid(AccT& acc, const pg8::Unit& u, int wr, int wc, int fr, int fq) const { apply<true>(acc, u, wr, wc, fr, fq); }
    __device__ __forceinline__ void operator()(const AccT& acc, const pg8::Unit& u, int wr, int wc, int fr, int fq) const { apply<false>(const_cast<AccT&>(acc), u, wr, wc, fr, fq); }
};
struct EpiResid {
    const float* rinv; bf16_t* h1b; float* ssq; unsigned char* h1b8;
    __device__ __forceinline__ void mid(AccT& acc, const pg8::Unit&, int, int, int, int) const {
#pragma unroll
        for (int ai = 0; ai < 2; ++ai)
#pragma unroll
            for (int bj = 0; bj < 2; ++bj)
#pragma unroll
                for (int m = 0; m < 4; ++m) { acc[ai][bj][m][0] *= 1.0f / (32.0f * MG_SCALE); acc[ai][bj][m][1] *= 1.0f / (32.0f * MG_SCALE); }
    }
    __device__ __forceinline__ void operator()(const AccT& acc, const pg8::Unit& u, int wr, int wc, int fr, int fq) const {
        const int row0 = u.pm * 256 + wr * 64 + fr, col0 = u.pn * 256 + wc * 32 + 8 * fq;
        float ri[2][4];
#pragma unroll
        for (int ai = 0; ai < 2; ++ai)
#pragma unroll
            for (int m = 0; m < 4; ++m) ri[ai][m] = rinv[(size_t)(row0 + ai * 128 + m * 16)];
#pragma unroll
        for (int ai = 0; ai < 2; ++ai) {
            u32x4 xv[4][2];
#pragma unroll
            for (int m = 0; m < 4; ++m)
#pragma unroll
                for (int bj = 0; bj < 2; ++bj) xv[m][bj] = *(const u32x4*)(h1b + (size_t)(row0 + ai * 128 + m * 16) * 1024 + col0 + bj * 128);
#pragma unroll
            for (int mp = 0; mp < 2; ++mp) { u32x2 w8p[2][2];
#pragma unroll
              for (int mm = 0; mm < 2; ++mm) { const int m = 2 * mp + mm; const size_t r = (size_t)(row0 + ai * 128 + m * 16); float ss = 0.f; const float rm = ri[ai][m];
#pragma unroll
                for (int bj = 0; bj < 2; ++bj) { const u32x4 h = xv[m][bj]; const f32x4 a0 = acc[ai][bj][m][0], a1 = acc[ai][bj][m][1];
                    const f32x4 v0 = {bf_lo(h.x) * rm + a0[0], bf_hi(h.x) * rm + a0[1], bf_lo(h.y) * rm + a0[2], bf_hi(h.y) * rm + a0[3]}, v1 = {bf_lo(h.z) * rm + a1[0], bf_hi(h.z) * rm + a1[1], bf_lo(h.w) * rm + a1[2], bf_hi(h.w) * rm + a1[3]};
                    ss += (v0[0] * v0[0] + v0[1] * v0[1]) + (v0[2] * v0[2] + v0[3] * v0[3]) + (v1[0] * v1[0] + v1[1] * v1[1]) + (v1[2] * v1[2] + v1[3] * v1[3]);
                    u32x4 w; w.x = cvt_pk_bf16(v0[0], v0[1]); w.y = cvt_pk_bf16(v0[2], v0[3]); w.z = cvt_pk_bf16(v1[0], v1[1]); w.w = cvt_pk_bf16(v1[2], v1[3]);
                    *(u32x4*)(h1b + r * 1024 + col0 + bj * 128) = w;
                    u32x2 w8 = {0u, 0u};
                    w8.x = __builtin_amdgcn_cvt_pk_fp8_f32(v0[0], v0[1], w8.x, false); w8.x = __builtin_amdgcn_cvt_pk_fp8_f32(v0[2], v0[3], w8.x, true);
                    w8.y = __builtin_amdgcn_cvt_pk_fp8_f32(v1[0], v1[1], w8.y, false); w8.y = __builtin_amdgcn_cvt_pk_fp8_f32(v1[2], v1[3], w8.y, true);
                    w8p[mm][bj] = w8; }
                ss += shfl_xor_local(ss, 16); ss += shfl_xor_local(ss, 32);
                if (fq == 0) ssq[r * 16 + u.pn * 4 + wc] = ss; }
              { unsigned char* p8 = h1b8 + (size_t)(row0 + ai * 128 + (2 * mp + (fq & 1)) * 16) * 1024 + (col0 - 8 * fq) + 16 * (fq >> 1);
#pragma unroll
                for (int bj = 0; bj < 2; ++bj) *(u32x4*)(p8 + bj * 128) = widen16(w8p[0][bj], w8p[1][bj]); } }
        }
    }
};
constexpr float HH_SCALE = 8.0f;
struct EpiSwiGLU {
    unsigned char* ws;
    __device__ __forceinline__ void operator()(const AccT& acc, const pg8::Unit& u, int wr, int wc, int fr, int fq) const {
        bf16_t* const HH = (bf16_t*)(ws + WS_RB); const float* const rs = (const float*)(ws + WS_RS); const float* const cw = (const float*)(ws + WS_CW);
        int lr0 = wr * 64 + fr, col0 = u.pn * 128 + wc * 32 + 8 * fq;
        asm volatile("" : "+v"(lr0), "+v"(col0));
        float rv[2][4], cv[2][4];
#pragma unroll
        for (int ai = 0; ai < 2; ++ai)
#pragma unroll
            for (int m = 0; m < 4; ++m) { const int lr = lr0 + ai * 128 + m * 16; const bool valid = lr < u.cnt; const int ix = u.aux + (valid ? lr : 0);
                const float r = rs[ix] * (1.0f / 32.0f), c = cw[ix]; rv[ai][m] = r; cv[ai][m] = valid ? c * r * r * HH_SCALE : 0.f; }
#pragma unroll
        for (int ai = 0; ai < 2; ++ai)
#pragma unroll
            for (int mp = 0; mp < 2; ++mp) { u32x2 wp[2];
#pragma unroll
              for (int mm = 0; mm < 2; ++mm) { const int m = 2 * mp + mm; const float nr = -rv[ai][m] * LOG2E, k = cv[ai][m];
                float o[8];
#pragma unroll
                for (int n = 0; n < 2; ++n)
#pragma unroll
                    for (int i = 0; i < 4; ++i) { const float a1 = acc[ai][0][m][n][i], a3 = acc[ai][1][m][n][i];
                        o[4 * n + i] = a1 * a3 * k * __builtin_amdgcn_rcpf(1.0f + __builtin_amdgcn_exp2f(a1 * nr)); }
                u32x2 w = {0u, 0u};
                w.x = __builtin_amdgcn_cvt_pk_fp8_f32(o[0], o[1], w.x, false); w.x = __builtin_amdgcn_cvt_pk_fp8_f32(o[2], o[3], w.x, true);
                w.y = __builtin_amdgcn_cvt_pk_fp8_f32(o[4], o[5], w.y, false); w.y = __builtin_amdgcn_cvt_pk_fp8_f32(o[6], o[7], w.y, true);
                wp[mm] = w; }
              { const int lr = lr0 + ai * 128 + (2 * mp + (fq & 1)) * 16;
                *(u32x4*)((unsigned char*)HH + (size_t)(u.hrow + lr) * 256 + (col0 - 8 * fq) + 16 * (fq >> 1)) = widen16(wp[0], wp[1]); } }
    }
};
template <bool FINAL> struct EpiScatter {
    bf16_t* hb; float* out; const int* tok;
    __device__ __forceinline__ void operator()(const AccT& acc, const pg8::Unit& u, int wr, int wc, int fr, int fq) const {
        const int lr0 = wr * 64 + fr, col0 = u.pn * 256 + wc * 32 + 8 * fq;
        int tk[2][4]; bool ok[2][4];
#pragma unroll
        for (int ai = 0; ai < 2; ++ai)
#pragma unroll
            for (int m = 0; m < 4; ++m) { const int lr = lr0 + ai * 128 + m * 16; ok[ai][m] = lr < u.cnt; tk[ai][m] = tok[u.aux + (ok[ai][m] ? lr : 0)]; }
#pragma unroll
        for (int ai = 0; ai < 2; ++ai) {
            u32x4 hv[4][2];
#pragma unroll
            for (int m = 0; m < 4; ++m)
#pragma unroll
                for (int bj = 0; bj < 2; ++bj) hv[m][bj] = *(const u32x4*)(hb + (size_t)tk[ai][m] * 1024 + col0 + bj * 128);
#pragma unroll
            for (int m = 0; m < 4; ++m) if (ok[ai][m]) {
#pragma unroll
                for (int bj = 0; bj < 2; ++bj) { const u32x4 h = hv[m][bj]; const f32x4 a0 = acc[ai][bj][m][0] * (1.0f / (32.0f * HH_SCALE)), a1 = acc[ai][bj][m][1] * (1.0f / (32.0f * HH_SCALE));
                    const f32x4 v0 = {bf_lo(h.x) + a0[0], bf_hi(h.x) + a0[1], bf_lo(h.y) + a0[2], bf_hi(h.y) + a0[3]}, v1 = {bf_lo(h.z) + a1[0], bf_hi(h.z) + a1[1], bf_lo(h.w) + a1[2], bf_hi(h.w) + a1[3]};
                    if (FINAL) { float* p = out + (size_t)tk[ai][m] * 1024 + col0 + bj * 128; *(f32x4*)p = v0; *(f32x4*)(p + 4) = v1; }
                    else { u32x4 w; w.x = cvt_pk_bf16(v0[0], v0[1]); w.y = cvt_pk_bf16(v0[2], v0[3]); w.z = cvt_pk_bf16(v1[0], v1[1]); w.w = cvt_pk_bf16(v1[2], v1[3]); *(u32x4*)(hb + (size_t)tk[ai][m] * 1024 + col0 + bj * 128) = w; } } }
        }
    }
};

template <int NSUB, bool G1, int ES = 2> struct MoeOrder {
    const volatile LAS int* pre; const volatile LAS int* cnt; int l0, nl, stride, first; const char* A; const char* W; const int* tok; int id0, id1;
    __device__ bool next(int i, pg8::Unit& u) const {
        const int id = id0 + i * stride + first; if (id1 >= 0 && id >= id1) return false; const int t0 = __builtin_amdgcn_readfirstlane(pre[l0]), total = (__builtin_amdgcn_readfirstlane(pre[l0 + nl]) - t0) * NSUB; if (id >= total) return false;
        const int tile = t0 + id / NSUB, sub = id % NSUB; int l = l0; { int hi_ = l0 + nl; while (hi_ - l > 1) { const int mid_ = (l + hi_) >> 1; if (tile >= pre[mid_]) l = mid_; else hi_ = mid_; } }
        l = __builtin_amdgcn_readfirstlane(l);
        const int mt = __builtin_amdgcn_readfirstlane(tile - pre[l]), e = l & 31;
        u.pm = mt; u.pn = sub; u.cnt = __builtin_amdgcn_readfirstlane(min(256, cnt[l] - mt * 256)); u.aux = l * LCAP + mt * 256; u.hrow = tile * 256; u.tok = tok + u.aux;
        if (G1) { u.a = A; u.b = W + ((size_t)e * 512 + (size_t)sub * 256) * 1024; }
        else    { u.a = A + (size_t)tile * 256 * 256 * ES; u.b = W + ((size_t)e * 1024 + (size_t)sub * 256) * 256 * ES; }
        return true;
    }
};

namespace attn_body {
using bf16 = __hip_bfloat16;
using bf16x8 = __attribute__((ext_vector_type(8))) short;
using s16x4 = __attribute__((ext_vector_type(4))) short;
using f32x16 = __attribute__((ext_vector_type(16))) float;
using u32x4 = __attribute__((ext_vector_type(4))) unsigned;
constexpr int D = 64, DM = 512, ODM = 1024;
constexpr int NW = 8, QBLK = 32, QB = QBLK * NW, KVBLK = 64;
__device__ __forceinline__ int crow(int r, int hi) { return (r & 3) + 8 * (r >> 2) + 4 * hi; }
#define SBAR() __builtin_amdgcn_sched_barrier(0)
__device__ __forceinline__ void cmask(f32x16& p0, f32x16& p1, int jb, int qrel, int hi) {
    const float NEG = -INFINITY; int kb = 64 * jb + 4 * hi;
#pragma unroll
    for (int r = 0; r < 16; ++r) { int kv = kb + (r & 3) + 8 * (r >> 2); if (kv > qrel) p0[r] = NEG; if (kv + 32 > qrel) p1[r] = NEG; }
}
constexpr int NSLOT = 3, SLOTB = 8192;
constexpr int LDS_K = 0, LDS_V = NSLOT * SLOTB, LDS_WS = 2 * NSLOT * SLOTB, LDS_OST = LDS_WS + NW * 64 * 4, LDS_KB = LDS_OST + NW * 4096, LDS_KBR = LDS_KB + LP * 4, LDS_BYTES = LDS_KBR + LP * 4;
__device__ __forceinline__ void glds16(const void* gsrc, unsigned lds_dst) { unsigned keep;
    asm volatile("s_mov_b32 %0, m0\n\ts_mov_b32 m0, %2\n\ts_nop 0\n\tglobal_load_lds_dwordx4 %1, off\n\ts_mov_b32 m0, %0" : "=&s"(keep) : "v"(gsrc), "s"(lds_dst) : "memory"); }
typedef float f32x2_t __attribute__((ext_vector_type(2))); typedef __bf16 bf16x2_t __attribute__((ext_vector_type(2)));
__device__ __forceinline__ unsigned cvtpk_s(float lo, float hi) { f32x2_t v = {lo, hi}; bf16x2_t b = __builtin_convertvector(v, bf16x2_t); return __builtin_bit_cast(unsigned, b); }
#define WAIT_BAR(N) asm volatile("s_waitcnt vmcnt(" #N ") lgkmcnt(0)\n\ts_barrier" ::: "memory")
typedef __attribute__((address_space(3))) const char* lds_cptr;
typedef __attribute__((address_space(3))) const float* lds_fptr;
typedef short v4i16_t __attribute__((ext_vector_type(4)));
__device__ __forceinline__ void cinit(f32x16& c0, f32x16& c1, lds_fptr kb, int hi) {
#pragma unroll
    for (int g = 0; g < 4; ++g) { const f32x4 a = *(const LAS f32x4*)(kb + 8 * g + 4 * hi), b = *(const LAS f32x4*)(kb + 32 + 8 * g + 4 * hi);
#pragma unroll
        for (int i = 0; i < 4; ++i) { c0[4 * g + i] = a[i]; c1[4 * g + i] = b[i]; } }
}
typedef int v8i_t __attribute__((ext_vector_type(8)));
typedef int v4i_t __attribute__((ext_vector_type(4)));
#define CAT8(lo, hi) __builtin_shufflevector(lo, hi, 0, 1, 2, 3, 4, 5, 6, 7)
#define MFMA_QK8(kf_, qf_, c_) __builtin_amdgcn_mfma_scale_f32_32x32x64_f8f6f4(kf_, qf_, c_, 0, 0, 0, 0x7F7F7F7F, 0, 0x7C7C7C7C)
__device__ __forceinline__ void qkt(f32x16& p0, f32x16& p1, const char* Kslot, const v8i_t qr8, const f32x16& c0, const f32x16& c1, int r32, int hi) {
    const char* kb = Kslot + hi * 2048 + r32 * 16;
    const v4i_t k00 = *reinterpret_cast<const v4i_t*>(kb), k01 = *reinterpret_cast<const v4i_t*>(kb + 1024), k10 = *reinterpret_cast<const v4i_t*>(kb + 512), k11 = *reinterpret_cast<const v4i_t*>(kb + 1536);
    p0 = MFMA_QK8(CAT8(k00, k01), qr8, c0); p1 = MFMA_QK8(CAT8(k10, k11), qr8, c1);
}
__device__ __forceinline__ void kload1(v4i_t* kq, lds_cptr kp, int j) { kq[j] = *(const LAS v4i_t*)(kp + (j >> 1) * 512 + (j & 1) * 1024); }
__device__ __forceinline__ void kload8(v4i_t* kq, lds_cptr kp) { kload1(kq, kp, 0); kload1(kq, kp, 1); kload1(kq, kp, 2); kload1(kq, kp, 3); }
__device__ __forceinline__ s16x4 vtr(lds_cptr p) { return __builtin_bit_cast(s16x4, __builtin_amdgcn_ds_read_tr16_b64_v4i16((LAS v4i16_t*)p)); }
__device__ __forceinline__ void pv(f32x16* o, int vb, bf16x8 pa0, bf16x8 pa1, bf16x8 pa2, bf16x8 pa3) {
#pragma unroll
    for (int d0 = 0; d0 < 2; ++d0) { s16x4 lo[4], hi[4];
#pragma unroll
        for (int ks = 0; ks < 4; ++ks) {
            asm volatile("ds_read_b64_tr_b16 %0,%1 offset:%c2" : "=&v"(lo[ks]) : "v"(vb), "i"(d0 * 4096 + ks * 1024) : "memory");
            asm volatile("ds_read_b64_tr_b16 %0,%1 offset:%c2" : "=&v"(hi[ks]) : "v"(vb), "i"(d0 * 4096 + ks * 1024 + 512) : "memory"); }
        asm volatile("s_waitcnt lgkmcnt(0)" ::: "memory"); SBAR();
#define PK(k) (bf16x8){lo[k][0], lo[k][1], lo[k][2], lo[k][3], hi[k][0], hi[k][1], hi[k][2], hi[k][3]}
        o[d0] = __builtin_amdgcn_mfma_f32_32x32x16_bf16(pa0, PK(0), o[d0], 0, 0, 0);
        o[d0] = __builtin_amdgcn_mfma_f32_32x32x16_bf16(pa1, PK(1), o[d0], 0, 0, 0);
        o[d0] = __builtin_amdgcn_mfma_f32_32x32x16_bf16(pa2, PK(2), o[d0], 0, 0, 0);
        o[d0] = __builtin_amdgcn_mfma_f32_32x32x16_bf16(pa3, PK(3), o[d0], 0, 0, 0);
#undef PK
    }
}
__device__ __forceinline__ void attn_kv_prefetch(int b, int h, const bf16* __restrict__ K, const bf16* __restrict__ V, char* shm, const int wave_s) {
    const int lane = lane_id(), wid = wave_s;
    const bf16 *Kh = K + (long)b * LP * DM + h * D, *Vh = V + (long)b * LP * DM + h * D;
    const unsigned lds0 = (unsigned)(uintptr_t)shm;
    const bf16* ksrc = Kh + (long)lane * DM + wid * 8;
    const bf16* vsrc = Vh + (long)(16 * (wid & 3) + (lane >> 2)) * DM + (wid >> 2) * 32 + (lane & 3) * 8;
    const unsigned kdst = lds0 + LDS_K + wid * 1024, vdst = lds0 + LDS_V + wid * 1024;
    glds16(ksrc, (unsigned)__builtin_amdgcn_readfirstlane(kdst)); glds16(vsrc, (unsigned)__builtin_amdgcn_readfirstlane(vdst));
    glds16(ksrc + (long)KVBLK * DM, (unsigned)__builtin_amdgcn_readfirstlane(kdst + SLOTB));
}
constexpr float O_SCALE = 4.0f;
template <int THRL> __device__ __forceinline__ void attn_unit(int b, int h, int qb, const bf16* Q, const bf16* __restrict__ K, const bf16* __restrict__ V, bf16* O, char* shm, const int wave_s, const float cb, const bool kv_pre) {
    int tid_ = wave_s * 64 + lane_id(); asm volatile("" : "+v"(tid_));
    const int tid = tid_, lane = tid & 63, r32 = lane & 31, hi = lane >> 5; const int wid = wave_s;
    const int q0 = qb * QB;
    const bf16* Qw = Q + ((long)b * SEQ_ + q0 + wid * QBLK) * DM + h * D;
    const bf16 *Kh = K + (long)b * LP * DM + h * D, *Vh = V + (long)b * LP * DM + h * D;
    const unsigned lds0 = (unsigned)(uintptr_t)shm;
    const bf16* ksrc = Kh + (long)lane * DM + wid * 8;
    const bf16* vsrc = Vh + (long)(16 * (wid & 3) + (lane >> 2)) * DM + (wid >> 2) * 32 + (lane & 3) * 8;
    const unsigned kdst = lds0 + LDS_K + wid * 1024, vdst = lds0 + LDS_V + wid * 1024;
#define DMA_K(t, slot) glds16(ksrc + (long)(t) * KVBLK * DM, (unsigned)__builtin_amdgcn_readfirstlane(kdst + (slot)))
#define DMA_V(t, slot) glds16(vsrc + (long)(t) * KVBLK * DM, (unsigned)__builtin_amdgcn_readfirstlane(vdst + (slot)))
    const int vb0 = (int)(lds0 + LDS_V) + ((lane >> 4) & 1) * 32 + (lane & 3) * 8 + (4 * hi + ((lane & 15) >> 2)) * 64;
    const char* Kbase = shm + LDS_K; v4i_t kq[4];
    const lds_cptr shm3 = (lds_cptr)shm; const lds_cptr kp0 = shm3 + LDS_K + hi * 2048 + r32 * 16; const lds_cptr vp0 = shm3 + LDS_V + ((lane >> 4) & 1) * 32 + (lane & 3) * 8 + (4 * hi + ((lane & 15) >> 2)) * 64;
    const lds_fptr kbl = (lds_fptr)(shm3 + LDS_KB); const lds_fptr kbr = (lds_fptr)(shm3 + LDS_KBR);
    const int NT = 4 * qb + 5;
    if (!kv_pre) { DMA_K(0, 0); DMA_V(0, 0); DMA_K(1, SLOTB); }
    { const float rref = kbl[64 + q0 + 128] + cb;
      LAS float* kw = (LAS float*)(shm3 + LDS_KBR);
      for (int i = tid; i < 64 * NT; i += 512) kw[i] = kbl[i] - rref; }
    v8i_t qr8; { const char* qp = (const char*)Qw + (long)r32 * (DM * 2) + hi * 32; const v4i_t q0_ = *reinterpret_cast<const v4i_t*>(qp), q1_ = *reinterpret_cast<const v4i_t*>(qp + 16); qr8 = CAT8(q0_, q1_); }
    const int qrel = wid * QBLK + r32;
    f32x16 o[2]; o[0] = f32x16{}; o[1] = f32x16{}; f32x16 lacc = f32x16{};
    bf16x8 ones; { const short one = (short)0x3F80; ones = (bf16x8){one, one, one, one, one, one, one, one}; asm volatile("" : "+v"(ones)); }
#define CMASK(P0, P1, t) do { int jb_ = (t) - (NT - 4); if (jb_ >= 0) cmask(P0, P1, jb_, qrel, hi); } while (0)
    f32x16 pA0, pA1, pB0, pB1;
    int sl_prev = 0, sl_cur = 0, sl_next = SLOTB;
#define ROT() do { sl_prev = sl_cur; sl_cur = sl_next; sl_next = (sl_next == (NSLOT - 1) * SLOTB) ? 0 : sl_next + SLOTB; } while (0)
    DMA_K(2, 2 * SLOTB);
    WAIT_BAR(3);
    { f32x16 ci0, ci1; cinit(ci0, ci1, kbr, hi);
      qkt(pB0, pB1, Kbase, qr8, ci0, ci1, r32, hi); }
    CMASK(pB0, pB1, 0);
    _Pragma("unroll") for (int r = 0; r < 16; ++r) { pB0[r] = __builtin_amdgcn_exp2f(pB0[r]); pB1[r] = __builtin_amdgcn_exp2f(pB1[r]); }
    WAIT_BAR(0);
    DMA_K(3, 0); DMA_V(1, SLOTB);
    ROT();
    kload8(kq, kp0 + sl_cur);
    WAIT_BAR(2);
    s16x4 vlo[8], vhi[8]; u32x4 pw0, pw1, pw2, pw3;
#define PKW(P, B) cvtpk_s(P[B], P[B + 1])
#define PAF(k) __builtin_bit_cast(bf16x8, pw##k)
#define VFR(i) (bf16x8){vlo[i][0], vlo[i][1], vlo[i][2], vlo[i][3], vhi[i][0], vhi[i][1], vhi[i][2], vhi[i][3]}
#define PIN(x) asm volatile("" : "+v"(x))
#define GAPA(MF, W0, W1, PW) do { MF; W0; W1; PIN(PW); } while (0)
#define EX(v) __builtin_amdgcn_exp2f(v)
#define GAPB3(MF, X, B) do { MF; X[B] = EX(X[B]); X[B + 1] = EX(X[B + 1]); X[B + 2] = EX(X[B + 2]); PIN(X); SBAR(); } while (0)
#define GAPL(k, X, B) do { lacc = __builtin_amdgcn_mfma_f32_32x32x16_bf16(PAF(k), ones, lacc, 0, 0, 0); X[B] = EX(X[B]); PIN(X); SBAR(); } while (0)
#define GAPL2(k, X, B, Y, B2) do { lacc = __builtin_amdgcn_mfma_f32_32x32x16_bf16(PAF(k), ones, lacc, 0, 0, 0); X[B] = EX(X[B]); Y[B2] = EX(Y[B2]); PIN(X); PIN(Y); SBAR(); } while (0)
#define VRD(i) do { vlo[i] = vtr(vp_ + (((i) >> 2) * 4096 + ((i) & 3) * 1024)); vhi[i] = vtr(vp_ + (((i) >> 2) * 4096 + ((i) & 3) * 1024 + 512)); } while (0)
#define KRD(G, j) do { if (G) { kload1(kq, kp0 + sl_next, j); } } while (0)
#define STEP(C0, C1, P0, P1, t, GK, GV, GL) do { SBAR(); \
    const lds_cptr vp_ = vp0 + sl_prev; \
    f32x16 ci0_, ci1_; cinit(ci0_, ci1_, kbr + 64 * (t), hi); SBAR(); \
    VRD(0); \
    GAPA(C0 = MFMA_QK8(CAT8(kq[0], kq[1]), qr8, ci0_), pw0[0] = PKW(P0, 0), pw0[1] = PKW(P0, 2), pw0); \
    VRD(4); GAPA(, pw0[2] = PKW(P0, 4), pw0[3] = PKW(P0, 6), pw0); \
    VRD(1); GAPA(, pw1[0] = PKW(P0, 8), pw1[1] = PKW(P0, 10), pw1); \
    VRD(5); GAPA(, pw1[2] = PKW(P0, 12), pw1[3] = PKW(P0, 14), pw1); \
    VRD(2); GAPA(C1 = MFMA_QK8(CAT8(kq[2], kq[3]), qr8, ci1_), pw2[0] = PKW(P1, 0), pw2[1] = PKW(P1, 2), pw2); \
    VRD(6); GAPA(, pw2[2] = PKW(P1, 4), pw2[3] = PKW(P1, 6), pw2); \
    VRD(3); GAPA(, pw3[0] = PKW(P1, 8), pw3[1] = PKW(P1, 10), pw3); \
    VRD(7); GAPA(, pw3[2] = PKW(P1, 12), pw3[3] = PKW(P1, 14), pw3); \
    if (GK) { DMA_K((t) + 3, sl_cur); } if (GV) { DMA_V((t) + 1, sl_next); } \
    CMASK(C0, C1, t); \
    SBAR(); \
    GAPB3(o[0] = __builtin_amdgcn_mfma_f32_32x32x16_bf16(PAF(0), VFR(0), o[0], 0, 0, 0), C0, 0); \
    GAPB3(o[1] = __builtin_amdgcn_mfma_f32_32x32x16_bf16(PAF(0), VFR(4), o[1], 0, 0, 0), C0, 3); \
    GAPL2(0, C0, 6, C0, 7); \
    KRD(GL, 0); GAPB3(o[0] = __builtin_amdgcn_mfma_f32_32x32x16_bf16(PAF(1), VFR(1), o[0], 0, 0, 0), C0, 8); \
    KRD(GL, 1); GAPB3(o[1] = __builtin_amdgcn_mfma_f32_32x32x16_bf16(PAF(1), VFR(5), o[1], 0, 0, 0), C0, 11); \
    GAPL2(1, C0, 14, C0, 15); \
    KRD(GL, 2); GAPB3(o[0] = __builtin_amdgcn_mfma_f32_32x32x16_bf16(PAF(2), VFR(2), o[0], 0, 0, 0), C1, 0); \
    KRD(GL, 3); GAPB3(o[1] = __builtin_amdgcn_mfma_f32_32x32x16_bf16(PAF(2), VFR(6), o[1], 0, 0, 0), C1, 3); \
    GAPL2(2, C1, 6, C1, 7); \
    GAPB3(o[0] = __builtin_amdgcn_mfma_f32_32x32x16_bf16(PAF(3), VFR(3), o[0], 0, 0, 0), C1, 8); \
    GAPB3(o[1] = __builtin_amdgcn_mfma_f32_32x32x16_bf16(PAF(3), VFR(7), o[1], 0, 0, 0), C1, 11); \
    GAPL2(3, C1, 14, C1, 15); \
    } while (0)
#define ENDW(tt) do { if ((tt) + 3 < NT) { WAIT_BAR(2); } else if ((tt) + 2 < NT) { WAIT_BAR(1); } else { WAIT_BAR(0); } } while (0)
    STEP(pA0, pA1, pB0, pB1, 1, (1 + 3 < NT), (1 + 1 < NT), (1 + 1 < NT)); ENDW(1); ROT();
    int t = 2;
#undef CMASK
#define CMASK(P0, P1, t) do { } while (0)
    for (; t + 5 < NT; t += 2) {
        STEP(pB0, pB1, pA0, pA1, t, true, true, true);       WAIT_BAR(2); ROT();
        STEP(pA0, pA1, pB0, pB1, t + 1, true, true, true);   WAIT_BAR(2); ROT();
    }
#undef CMASK
#define CMASK(P0, P1, t) do { int jb_ = (t) - (NT - 4); if (jb_ >= 0) cmask(P0, P1, jb_, qrel, hi); } while (0)
    for (; t + 1 < NT; t += 2) {
        STEP(pB0, pB1, pA0, pA1, t, (t + 3 < NT), (t + 1 < NT), (t + 1 < NT));         ENDW(t);     ROT();
        STEP(pA0, pA1, pB0, pB1, t + 1, (t + 4 < NT), (t + 2 < NT), (t + 2 < NT));     ENDW(t + 1); ROT();
    }
    STEP(pB0, pB1, pA0, pA1, NT - 1, false, false, false);
    { pw0 = (u32x4){PKW(pB0, 0), PKW(pB0, 2), PKW(pB0, 4), PKW(pB0, 6)}; pw1 = (u32x4){PKW(pB0, 8), PKW(pB0, 10), PKW(pB0, 12), PKW(pB0, 14)}; pw2 = (u32x4){PKW(pB1, 0), PKW(pB1, 2), PKW(pB1, 4), PKW(pB1, 6)}; pw3 = (u32x4){PKW(pB1, 8), PKW(pB1, 10), PKW(pB1, 12), PKW(pB1, 14)};
      SBAR(); pv(o, vb0 + sl_cur, PAF(0), PAF(1), PAF(2), PAF(3));
      lacc = __builtin_amdgcn_mfma_f32_32x32x16_bf16(PAF(0), ones, lacc, 0, 0, 0); lacc = __builtin_amdgcn_mfma_f32_32x32x16_bf16(PAF(1), ones, lacc, 0, 0, 0);
      lacc = __builtin_amdgcn_mfma_f32_32x32x16_bf16(PAF(2), ones, lacc, 0, 0, 0); lacc = __builtin_amdgcn_mfma_f32_32x32x16_bf16(PAF(3), ones, lacc, 0, 0, 0); }
#undef PKW
#undef PAF
#undef VFR
#undef PIN
#undef GAPA
#undef GAPB3
#undef GAPL
#undef GAPL2
#undef EX
#undef VRD
#undef KRD
#undef STEP
#undef ENDW
    unsigned char* Ow = (unsigned char*)O + ((long)b * SEQ_ + q0 + wid * QBLK) * 1536 + h * D;
    { LAS unsigned char* stg = (LAS unsigned char*)(shm + LDS_OST) + wid * 2048;
#pragma unroll
      for (int r = 0; r < 16; ++r) { const int orow = crow(r, hi); const float rl = __builtin_amdgcn_rcpf(lacc[r]) * O_SCALE;
        const unsigned pk = (unsigned)__builtin_amdgcn_cvt_pk_fp8_f32(o[0][r] * rl, o[1][r] * rl, 0, false);
        stg[orow * 64 + r32] = (unsigned char)(pk & 0xffu); stg[orow * 64 + 32 + r32] = (unsigned char)((pk >> 8) & 0xffu); }
      asm volatile("s_waitcnt lgkmcnt(0)" ::: "memory");
#pragma unroll
      for (int i = 0; i < 2; ++i) { const int row = i * 16 + (lane >> 2), ch = lane & 3; const u32x4 v = *(const LAS u32x4*)(stg + row * 64 + ch * 16); *(u32x4*)(Ow + (long)row * 1536 + ch * 16) = v; } }
    asm volatile("s_waitcnt lgkmcnt(0)\n\ts_barrier" ::: "memory");
#undef DMA_K
#undef DMA_V
#undef CMASK
#undef ROT
}
#undef SBAR
#undef WAIT_BAR
}


#define XB_TMO      128
#define XB_XCNT(j)  (256  + 64 * (j))
#define XB_XSUB(j)  (1280 + 64 * (j))
#define XB_XGEN(j)  (2304 + 64 * (j))
#define XB_TOP      3328
#define XB_TOPGEN   3392
#define XCD_BAR_WORDS 3456
#define XB_SPIN_CAP (1u << 18)
__device__ __forceinline__ unsigned xb_ld(unsigned* p)              { return __hip_atomic_load(p, __ATOMIC_RELAXED, __HIP_MEMORY_SCOPE_AGENT); }
__device__ __forceinline__ unsigned xb_add(unsigned* p, unsigned v) { return __hip_atomic_fetch_add(p, v, __ATOMIC_RELAXED, __HIP_MEMORY_SCOPE_AGENT); }
__device__ __forceinline__ unsigned xb_xcc_id() { return (unsigned)__builtin_amdgcn_s_getreg((3 << 11) | 20) & 0xFu; }
#define XB_SPIN(cond, bar) do { unsigned _sp = 0; while (cond) { __builtin_amdgcn_s_sleep(1); \
    if ((++_sp & 255u) == 0u) { if (xb_ld(&(bar)[XB_TMO])) break; if (_sp > XB_SPIN_CAP) { atomicAdd(&(bar)[XB_TMO], 1u); break; } } } } while (0)
__device__ __forceinline__ void xcd_barrier_post(unsigned* bar, const int wave_s) { if (wave_s == 0 && lane_id() == 0) (void)xb_add(&bar[XB_XCNT(xb_xcc_id())], 1u); }
__device__ __forceinline__ void xcd_barrier_complete(unsigned* bar, unsigned x, unsigned& nloc, unsigned& nx) {
    const unsigned G = gridDim.x * gridDim.y * gridDim.z;
    unsigned sum, cnt, mine, sp = 0u;
    for (;;) {
        sum = 0u; cnt = 0u; mine = 0u;
#pragma unroll
        for (unsigned j = 0; j < 16; ++j) { const unsigned c = xb_ld(&bar[XB_XCNT(j)]); sum += c; cnt += (c > 0u) ? 1u : 0u; mine = (j == x) ? c : mine; }
        if (sum == G) break;
        __builtin_amdgcn_s_sleep(1);
        if ((++sp & 255u) == 0u) { if (xb_ld(&bar[XB_TMO])) break; if (sp > XB_SPIN_CAP) { atomicAdd(&bar[XB_TMO], 1u); break; } }
    }
    nloc = mine > 0u ? mine : 1u; nx = cnt > 0u ? cnt : 1u;
}
struct XbNoWork { __device__ __forceinline__ void operator()() const {} };
template <class Work = XbNoWork>
__device__ __forceinline__ void xcd_barrier(unsigned* bar, volatile LAS unsigned* st, const int wave_s, const Work& work = Work()) {
    asm volatile("s_waitcnt vmcnt(0)" ::: "memory");
    __syncthreads();
    if (wave_s != 0) work();
    if (wave_s == 0 && lane_id() == 0) {
        const unsigned x = xb_xcc_id();
        __builtin_amdgcn_s_waitcnt(0);
        unsigned nloc = st[0], nx = st[1];
        if (nloc == 0u) { xcd_barrier_complete(bar, x, nloc, nx); st[0] = nloc; st[1] = nx; }
        const unsigned old = xb_add(&bar[XB_XSUB(x)], 1u);
        const unsigned gen = old / nloc;
        if (old + 1u == (gen + 1u) * nloc) {
            __builtin_amdgcn_fence(__ATOMIC_RELEASE, "agent");
            asm volatile("s_waitcnt vmcnt(0)" ::: "memory");
            (void)xb_add(&bar[XB_TOP], 1u);
        }
        {
            XB_SPIN(xb_ld(&bar[XB_TOP]) < (gen + 1u) * nx, bar);
            __builtin_amdgcn_fence(__ATOMIC_ACQUIRE, "agent");
            asm volatile("s_waitcnt vmcnt(0)" ::: "memory");
        }
    }
    __syncthreads();
}

struct Args {
    const float *x, *meta, *g_mix, *w_in, *b_forget, *gq, *gk, *w_up_attn, *w_pool, *pool_scale, *w_up_pool, *w_out, *g_ffn, *w_group, *b_group, *w_router, *b_router, *w1, *w3, *w2;
    float* out; unsigned char* ws;
};

__device__ __forceinline__ unsigned f2bf(float f) { unsigned u = __builtin_bit_cast(unsigned, f); return (u + 0x7fffu + ((u >> 16) & 1u)) >> 16; }
__device__ __forceinline__ unsigned pk2(float lo, float hi) { return f2bf(lo) | (f2bf(hi) << 16); }

constexpr int N_DEF_ = 3 * 4096;
struct TItem { const float* src; const float* ks; bf16_t* WT; int ldw, Kdim, k0, n0, row_off, mode; };
__device__ __forceinline__ void tp_load(const TItem& t, int lane, float (&v)[32]) {
    int sc0 = t.n0;
    if (t.mode == 1 || t.mode == 3) { if (t.n0 >= 2048) { const int L0 = t.n0 & 255; sc0 = 2056 + 1024 * ((L0 >> 5) & 1) + 128 * ((t.n0 - 2048) >> 8) + 32 * (L0 >> 6); } else if (t.n0 >= 1536) sc0 = t.n0 + 8; }
    const float* wp = t.src + (size_t)(t.k0 + (lane >> 5)) * t.ldw + sc0 + (lane & 31);
#pragma unroll
    for (int i = 0; i < 32; ++i) v[i] = __builtin_nontemporal_load(&wp[(size_t)(2 * i) * t.ldw]);
}
__device__ __forceinline__ void tp_finish(const TItem& t, int lane, float (&v)[32], LAS float* scr) {
    if (t.ks) {
#pragma unroll
        for (int i = 0; i < 32; ++i) v[i] *= t.ks[t.k0 + 2 * i + (lane >> 5)]; }
#pragma unroll
    for (int i = 0; i < 32; ++i) scr[(2 * i + (lane >> 5)) * 33 + (lane & 31)] = v[i];
    asm volatile("s_waitcnt lgkmcnt(0)" ::: "memory");
    const int c = lane & 7;
    if (t.mode == 4 || t.mode == 5) {
#pragma unroll
        for (int j = 0; j < 4; ++j) { const int nn = (lane >> 3) + 8 * j, n = t.n0 + nn; const LAS float* sp = scr + (8 * c) * 33 + nn;
            const int dr = (t.mode == 5) ? t.row_off + n : t.row_off + 256 * (n >> 7) + (n & 127);
            u32x2 o = {0u, 0u};
            o.x = __builtin_amdgcn_cvt_pk_fp8_f32(sp[0 * 33] * 32.f, sp[1 * 33] * 32.f, o.x, false); o.x = __builtin_amdgcn_cvt_pk_fp8_f32(sp[2 * 33] * 32.f, sp[3 * 33] * 32.f, o.x, true);
            o.y = __builtin_amdgcn_cvt_pk_fp8_f32(sp[4 * 33] * 32.f, sp[5 * 33] * 32.f, o.y, false); o.y = __builtin_amdgcn_cvt_pk_fp8_f32(sp[6 * 33] * 32.f, sp[7 * 33] * 32.f, o.y, true);
            *(u32x2*)((unsigned char*)t.WT + (size_t)dr * t.Kdim + t.k0 + 8 * c) = o; }
        asm volatile("s_waitcnt lgkmcnt(0)" ::: "memory");
        return; }
    if (t.mode == 3 || t.mode == 6) {
#pragma unroll
        for (int j = 0; j < 4; ++j) { const int nn = (lane >> 3) + 8 * j, n = t.n0 + nn; const LAS float* sp = scr + (8 * c) * 33 + nn; const int L = n & 255;
            const int dr = ((n & ~255) + (t.mode == 6 ? (n < 1024 ? 2560 : 1024) : -2048)) + 128 * ((L & 63) >> 5) + 32 * (L >> 6) + (L & 31);
            u32x2 o = {0u, 0u};
            o.x = __builtin_amdgcn_cvt_pk_fp8_f32(sp[0 * 33] * 32.f, sp[1 * 33] * 32.f, o.x, false); o.x = __builtin_amdgcn_cvt_pk_fp8_f32(sp[2 * 33] * 32.f, sp[3 * 33] * 32.f, o.x, true);
            o.y = __builtin_amdgcn_cvt_pk_fp8_f32(sp[4 * 33] * 32.f, sp[5 * 33] * 32.f, o.y, false); o.y = __builtin_amdgcn_cvt_pk_fp8_f32(sp[6 * 33] * 32.f, sp[7 * 33] * 32.f, o.y, true);
            *(u32x2*)((unsigned char*)t.WT + (size_t)dr * 1024 + t.k0 + 8 * c) = o; }
        asm volatile("s_waitcnt lgkmcnt(0)" ::: "memory");
        return; }
#pragma unroll
    for (int j = 0; j < 4; ++j) { const int nn = (lane >> 3) + 8 * j, n = t.n0 + nn; const LAS float* sp = scr + (8 * c) * 33 + nn;
        u32x4 o; o.x = pk2(sp[0 * 33], sp[1 * 33]); o.y = pk2(sp[2 * 33], sp[3 * 33]); o.z = pk2(sp[4 * 33], sp[5 * 33]); o.w = pk2(sp[6 * 33], sp[7 * 33]);
        int dr;
        if (t.mode == 0) dr = t.row_off + n;
        else if (t.mode == 1) { const int L = n & 255; dr = (n & ~255) + 128 * ((L & 63) >> 5) + 32 * (L >> 6) + (L & 31); }
        else dr = t.row_off + 256 * (n >> 7) + (n & 127);
        *(u32x4*)(t.WT + (size_t)dr * t.Kdim + t.k0 + 8 * c) = o; }
    asm volatile("s_waitcnt lgkmcnt(0)" ::: "memory");
}

template <int NR> __device__ __forceinline__ void p0_rows_load(const float* const (&xrow)[NR], int ln, f32x4 (&v)[NR][4]) {
#pragma unroll
    for (int r = 0; r < NR; ++r)
#pragma unroll
        for (int j = 0; j < 4; ++j) v[r][j] = __builtin_nontemporal_load(&((const f32x4*)xrow[r])[64 * j + ln]);
}
template <int NR, bool W8> __device__ __forceinline__ void p0_rows(const f32x4 (&v)[NR][4], bf16_t* ob, unsigned char* ob8, const int (&mrow)[NR], const LAS float* wf, int ln, float (&zo)[NR], float (&rso)[NR]) {
    float ss[NR], z[NR][8];
#pragma unroll
    for (int r = 0; r < NR; ++r) { ss[r] = 0.f;
#pragma unroll
        for (int h = 0; h < 8; ++h) z[r][h] = 0.f; }
#pragma unroll
    for (int j = 0; j < 4; ++j) {
#pragma unroll
        for (int r = 0; r < NR; ++r) ss[r] += (v[r][j].x * v[r][j].x + v[r][j].y * v[r][j].y) + (v[r][j].z * v[r][j].z + v[r][j].w * v[r][j].w);
#pragma unroll
        for (int h = 0; h < 8; ++h) { const f32x4 w = *(const LAS f32x4*)(wf + h * 1024 + 256 * j + 4 * ln);
#pragma unroll
            for (int r = 0; r < NR; ++r) z[r][h] += (v[r][j].x * w.x + v[r][j].y * w.y) + (v[r][j].z * w.z + v[r][j].w * w.w); }
        __builtin_amdgcn_sched_barrier(0); }
    const bool b5 = (ln & 32) != 0, b4 = (ln & 16) != 0, b3 = (ln & 8) != 0;
#pragma unroll
    for (int r = 0; r < NR; ++r) {
        const float rstd = 1.0f / sqrtf(wave_sum(ss[r]) * (1.f / DM_) + RMS_EPS);
        unsigned long long* o8 = (unsigned long long*)(ob + (size_t)mrow[r] * DM_) + ln; unsigned* o4 = (unsigned*)(ob8 + (size_t)mrow[r] * DM_) + ln;
#pragma unroll
        for (int j = 0; j < 4; ++j) { const f32x4 y = v[r][j] * rstd; o8[64 * j] = (unsigned long long)pk2(y.x, y.y) | ((unsigned long long)pk2(y.z, y.w) << 32);
            if constexpr (W8) { unsigned w8 = 0u; w8 = __builtin_amdgcn_cvt_pk_fp8_f32(y.x, y.y, w8, false); w8 = __builtin_amdgcn_cvt_pk_fp8_f32(y.z, y.w, w8, true); o4[64 * j] = w8; } }
        float a[4], bq[2];
#pragma unroll
        for (int i = 0; i < 4; ++i) { const float send = b5 ? z[r][i] : z[r][4 + i], keep = b5 ? z[r][4 + i] : z[r][i]; a[i] = keep + __shfl_xor(send, 32); }
#pragma unroll
        for (int i = 0; i < 2; ++i) { const float send = b4 ? a[i] : a[2 + i], keep = b4 ? a[2 + i] : a[i]; bq[i] = keep + __shfl_xor(send, 16); }
        float c = (b3 ? bq[1] : bq[0]) + __shfl_xor(b3 ? bq[0] : bq[1], 8);
        c += __shfl_xor(c, 4); c += __shfl_xor(c, 2); c += __shfl_xor(c, 1);
        zo[r] = c * rstd;
        rso[r] = rstd;
    }
}
__device__ __forceinline__ float log_sigmoid_f(float z) { return fminf(z, 0.f) - log1pf(expf(-fabsf(z))); }

__device__ __forceinline__ int bx_f() { int b = (int)blockIdx.x; asm volatile("" : "+s"(b)); return b; }
__device__ __forceinline__ int grid_f() { int g = (int)gridDim.x; asm volatile("" : "+s"(g)); return g; }
__device__ __forceinline__ int vcu_f() { const int g = grid_f(), b = bx_f(); return (g % 8 == 0) ? (b % 8) * (g / 8) + b / 8 : b; }
typedef const Args __attribute__((address_space(4)))* KArgsP;
__device__ __forceinline__ KArgsP kargs() { KArgsP p = (KArgsP)__builtin_amdgcn_kernarg_segment_ptr(); asm volatile("" : "+s"(p)); return p; }
__global__ void __launch_bounds__(512, 2) fwd_megakernel(Args args_unused) {
    extern __shared__ __attribute__((aligned(16))) unsigned char lds[];
    LAS unsigned char* L = (LAS unsigned char*)lds;
    const int wave = __builtin_amdgcn_readfirstlane(threadIdx.x >> 6);
#define tid (wave * 64 + lane_id())
#define lane lane_id()
#define G grid_f()
#define bx bx_f()
#define vcu vcu_f()
#define WSP(T, off) ((T*)(KA->ws + (off)))
#define ctl WSP(unsigned, WS_CTL)
#define Wmain WSP(bf16_t, WS_WMAIN)
#define Wg8 WSP(unsigned char, WS_WG8)
#define HN8 WSP(unsigned char, WS_HN8)
#define H1B8 WSP(unsigned char, WS_H1B8)
#define Wa WSP(bf16_t, WS_WA)
#define We WSP(bf16_t, WS_WE)
#define Wout WSP(bf16_t, WS_WOUT)
#define Wr WSP(bf16_t, WS_WR)
#define HNM WSP(bf16_t, WS_HNM)
#define LF WSP(float, WS_LF)
#define SSQ WSP(float, WS_SSQ)
#define RINV WSP(float, WS_RINV)
#define W13 WSP(bf16_t, WS_W13)
#define W2t WSP(bf16_t, WS_W2)
#define TOK WSP(int, WS_TOK)
#define RS WSP(float, WS_RS)
#define CWt WSP(float, WS_CW)
#define HN WSP(bf16_t, WS_RA)
#define YP WSP(bf16_t, WS_RA)
#define H1B WSP(bf16_t, WS_RA)
#define Gt WSP(bf16_t, WS_RB)
#define HH WSP(bf16_t, WS_RB)
#define Qb WSP(bf16_t, WS_Q)
#define Kb WSP(bf16_t, WS_K)
#define Vb WSP(bf16_t, WS_V)
#define Ub WSP(bf16_t, WS_U)
#define MG WSP(bf16_t, WS_MG)
#define Ob WSP(bf16_t, WS_O)
#define MIX WSP(bf16_t, WS_MIX)
#define gw (vcu * 8 + wave)
#define NGW (G * 8)
#define STAMP(k) do { if (PROBE_PHASE >= 0 && ((k) == PROBE_PHASE || (k) == PROBE_PHASE + 1) && blockIdx.x == 0 && wave == 0 && lane_id() == 0) ((volatile LAS unsigned long long*)(L + LDSX_OFF + 4096))[k] = __builtin_amdgcn_s_memrealtime(); } while (0)
    STAMP(0);
    volatile LAS unsigned* xbst = (volatile LAS unsigned*)(L + LDSX_OFF + 8192);
    if (wave == 0 && lane_id() < 2) xbst[lane_id()] = 0u;
    __syncthreads();
    { const KArgsP KA = kargs(); xcd_barrier_post(ctl + CW_XBAR, wave); }
#define GRID_BAR() do { const KArgsP KA = kargs(); xcd_barrier(ctl + CW_XBAR, xbst, wave); } while (0)
#define DEF_ITEM(t, r_) do { int r = (r_); if (r < 4096) { const int e = r / 128, q = r % 128; t = TItem{KA->w1 + (size_t)e * 1024 * 256, KA->g_ffn, W13, 256, 1024, 64 * (q / 8), 32 * (q % 8), e * 512, 4}; } \
        else if (r < 8192) { r -= 4096; const int e = r / 128, q = r % 128; t = TItem{KA->w3 + (size_t)e * 1024 * 256, KA->g_ffn, W13, 256, 1024, 64 * (q / 8), 32 * (q % 8), e * 512 + 128, 4}; } \
        else { r -= 8192; const int e = r / 128, q = r % 128; t = TItem{KA->w2 + (size_t)e * 256 * 1024, nullptr, W2t, 1024, 256, 64 * (q / 32), 32 * (q % 32), e * 1024, 5}; } } while (0)
#define GRID_BAR_D(start, end) do { const KArgsP KA = kargs(); xcd_barrier(ctl + CW_XBAR, xbst, wave, [&]() { LAS float* scr = (LAS float*)(L + wave * 16384); \
        for (int r0 = (start) + vcu * 7 + (wave - 1); r0 < (end); r0 += 2 * G * 7) { const int r1 = r0 + G * 7; const bool hb = r1 < (end);     \
            TItem ta, tb; float va[32], vb[32]; \
            DEF_ITEM(ta, r0); tp_load(ta, lane, va); if (hb) { DEF_ITEM(tb, r1); tp_load(tb, lane, vb); } \
            tp_finish(ta, lane, va, scr); if (hb) tp_finish(tb, lane, vb, scr); } }); } while (0)

    if (PH(0)) {
        const KArgsP KA = kargs();
        LAS float* wf = (LAS float*)L;
        for (int k = tid; k < 1024; k += 512) { const f32x4 a = *(const f32x4*)(KA->w_in + (size_t)k * 4104 + 1536), b = *(const f32x4*)(KA->w_in + (size_t)k * 4104 + 1540); const float g = KA->g_mix[k];
            wf[k] = a.x * g; wf[1024 + k] = a.y * g; wf[2048 + k] = a.z * g; wf[3072 + k] = a.w * g; wf[4096 + k] = b.x * g; wf[5120 + k] = b.y * g; wf[6144 + k] = b.z * g; wf[7168 + k] = b.w * g; }
        __syncthreads();
        constexpr int I_WE_ = 4 * 32 * 16;
        auto weff_items = [&]() {
        for (int it = gw; it < I_WE_; it += NGW) {
            const int r = it;
            {
                const int g = r / 512, cq = (r / 16) % 32, nb = r % 16, n = nb * 64 + lane;
                float a0 = 0.f, a1 = 0.f, a2 = 0.f, a3 = 0.f;
                const float* wp = KA->w_pool + ((size_t)g * 128 + cq * 4) * 128;
#pragma unroll 16
                for (int d = 0; d < 128; ++d) { const float wu = KA->w_up_pool[(size_t)(g * 128 + d) * 1024 + n] * KA->pool_scale[g * 128 + d];
                    a0 += wp[d] * wu; a1 += wp[128 + d] * wu; a2 += wp[256 + d] * wu; a3 += wp[384 + d] * wu; }
                u32x2 o; o.x = pk2(a0, a1); o.y = pk2(a2, a3);
                *(u32x2*)((unsigned char*)Wa + (size_t)n * 1536 + 512 + (g * 128 + cq * 4) * 2) = o;
            }
        }
        };
        if (wave & 1) weff_items();
        {
            const int ln = lane;
            const float bfh = KA->b_forget[ln >> 3];
            f32x4 va[4][4], vb[4][4];
#define P0_ROWPTRS(it_, xr_, orow_, mm_) do { _Pragma("unroll") for (int r = 0; r < 4; ++r) { mm_[r] = gw + (4 * (it_) + r) * NGW; xr_[r] = KA->x + (size_t)mm_[r] * DM_; orow_[r] = HN + (size_t)mm_[r] * DM_; } } while (0)
#define P0_ROWFIN(v_, orow_, mm_) do { float zo[4], rso[4]; p0_rows<4, true>(v_, HN, HN8, mm_, wf, ln, zo, rso); \
                if (ln == 0) { _Pragma("unroll") for (int r = 0; r < 4; ++r) RINV[mm_[r]] = 1.0f / rso[r]; } \
                if ((ln & 7) == 0) { _Pragma("unroll") for (int r = 0; r < 4; ++r) { const int b = mm_[r] >> 12, t = mm_[r] & 4095; LF[(size_t)(b * 8 + (ln >> 3)) * LP + 64 + t] = log_sigmoid_f(zo[r] + bfh); } } } while (0)
            { const float* xr[4]; bf16_t* oa[4]; bf16_t* ob[4]; int ma[4], mb[4];
              P0_ROWPTRS(0, xr, oa, ma); p0_rows_load<4>(xr, ln, va);
              P0_ROWPTRS(1, xr, ob, mb); p0_rows_load<4>(xr, ln, vb);
              P0_ROWFIN(va, oa, ma);
              P0_ROWPTRS(2, xr, oa, ma); p0_rows_load<4>(xr, ln, va);
              P0_ROWFIN(vb, ob, mb);
              P0_ROWPTRS(3, xr, ob, mb); p0_rows_load<4>(xr, ln, vb);
              P0_ROWFIN(va, oa, ma);
              P0_ROWFIN(vb, ob, mb); }
#undef P0_ROWPTRS
#undef P0_ROWFIN
            if (gw < NMETA) {
                const float* xr[1] = {KA->meta + (size_t)gw * DM_}; bf16_t* orow[1] = {HNM + (size_t)gw * DM_}; float zo[1], rso[1]; f32x4 v1[1][4];
                const int m1[1] = {0}; p0_rows_load<1>(xr, ln, v1); p0_rows<1, false>(v1, HNM + (size_t)gw * DM_, nullptr, m1, wf, ln, zo, rso);
                if ((ln & 7) == 0) { const float v = log_sigmoid_f(zo[0] + bfh);
#pragma unroll
                    for (int b = 0; b < NBATCH; ++b) LF[(size_t)(b * 8 + (ln >> 3)) * LP + 48 + gw] = v; }
            }
        }
        if (!(wave & 1)) weff_items();
        for (int i = bx * 512 + tid; i < 64 * 48; i += G * 512) LF[(size_t)(i / 48) * LP + (i % 48)] = 0.f;
        for (int i = bx * 512 + tid; i < NBATCH * 48 * 64; i += G * 512) { const int b = i / (48 * 64), r = (i / 64) % 48, c = (i % 64) * 8; const size_t off = ((size_t)(b * LP + r)) * 512 + c; const u32x4 z = {0u, 0u, 0u, 0u};
            *(u32x4*)(Kb + off) = z; *(u32x4*)(Vb + off) = z; *(u32x4*)(Ub + off) = z; }
        for (int i = bx * 512 + tid; i < 48 * 1024; i += G * 512) { const int j = i >> 10, k = i & 1023; float v = 0.f;
            if (j < 4) v = KA->w_group[k * 4 + j] * KA->g_ffn[k]; else if (j < 36) v = KA->w_router[k * 32 + (j - 4)] * KA->g_ffn[k];
            Wr[i] = (bf16_t)f2bf(v); }
        __syncthreads();
        LAS float* scr = (LAS float*)(L + wave * 16384);
        constexpr int I_MAIN = 16 * 128, I_WA = 8 * 32, I_WOUT = 16 * 32, I_W1 = NEXP * 16 * 8, I_W2 = NEXP * 4 * 32, I_WE = 4 * 32 * 16;
        constexpr int NITEMS = I_MAIN + I_WA + I_WOUT + 2 * I_W1 + I_W2 + I_WE;
        constexpr int I_V8 = 16 * 48;
        constexpr int NTR = I_MAIN + I_V8 + I_WA + I_WOUT;
        auto make_item = [&](int r) -> TItem {
            TItem t;
            if (r < I_MAIN) { const int n0 = 32 * (r % 128); t = TItem{KA->w_in, KA->g_mix, n0 >= 2048 ? (bf16_t*)Wg8 : Wmain, 4104, 1024, 64 * (r / 128), n0, 0, n0 >= 2048 ? 3 : 1}; return t; } r -= I_MAIN;
            if (r < I_V8) { t = TItem{KA->w_in, KA->g_mix, (bf16_t*)Wg8, 4104, 1024, 64 * (r / 48), 32 * (r % 48), 0, 6}; return t; } r -= I_V8;
            if (r < I_WA) { t = TItem{KA->w_up_attn, nullptr, Wa, 1024, 1536, 64 * (r / 32), 32 * (r % 32), 0, 5}; return t; } r -= I_WA;
            if (r < I_WOUT) { const int k0 = 64 * (r / 32);
                t = (k0 < 512) ? TItem{KA->w_out, nullptr, Wout, 1024, 1536, k0, 32 * (r % 32), 0, 5} : TItem{KA->w_out, nullptr, Wout - 256, 1024, 768, k0, 32 * (r % 32), 0, 0}; return t; } r -= I_WOUT;
            if (r < I_W1) { const int e = r / 128, q = r % 128; t = TItem{KA->w1 + (size_t)e * 1024 * 256, KA->g_ffn, W13, 256, 1024, 64 * (q / 8), 32 * (q % 8), e * 512, 4}; return t; } r -= I_W1;
            if (r < I_W1) { const int e = r / 128, q = r % 128; t = TItem{KA->w3 + (size_t)e * 1024 * 256, KA->g_ffn, W13, 256, 1024, 64 * (q / 8), 32 * (q % 8), e * 512 + 128, 4}; return t; } r -= I_W1;
            { const int e = r / 128, q = r % 128; t = TItem{KA->w2 + (size_t)e * 256 * 1024, nullptr, W2t, 1024, 256, 64 * (q / 32), 32 * (q % 32), e * 1024, 0}; return t; }
        };
        {
            const int ln = lane; float va[32], vb[32]; int it = gw;
            if (it < NTR) { TItem a = make_item(it); tp_load(a, ln, va);
                for (;;) {
                    const int itb = it + NGW; const bool hb = itb < NTR; TItem b = a; if (hb) { b = make_item(itb); tp_load(b, ln, vb); }
                    tp_finish(a, ln, va, scr); if (!hb) break;
                    const int ita = itb + NGW; const bool ha = ita < NTR; if (ha) { a = make_item(ita); tp_load(a, ln, va); }
                    tp_finish(b, ln, vb, scr); if (!ha) break;
                    it = ita; } }
        }
    }
    GRID_BAR_D(0, 3584);
    STAMP(1);

    if (PH(1)) {
        const KArgsP KA = kargs();
        if (bx < 24) {
            const int item = bx, typ = item >> 3, hh = item & 7, pn = 2 + 2 * typ + (hh >> 2), wcc = hh & 3;
            f32x4 c4[4] = {{0.f, 0.f, 0.f, 0.f}, {0.f, 0.f, 0.f, 0.f}, {0.f, 0.f, 0.f, 0.f}, {0.f, 0.f, 0.f, 0.f}};
            const int ln = lane, r16 = ln & 15, q4 = ln >> 4;
            bf16x8 af[4], bfr[4][4];
            float gkv[4];
#pragma unroll
            for (int ct = 0; ct < 4; ++ct) gkv[ct] = KA->gk[ct * 16 + r16];
#pragma unroll
            for (int k4 = 0; k4 < 4; ++k4) { const int kk = wave * 4 + k4; af[k4] = *(const bf16x8*)(HNM + (size_t)r16 * 1024 + kk * 32 + 8 * q4);
#pragma unroll
                for (int ct = 0; ct < 4; ++ct) { const int d = ct * 16 + r16;
                    bfr[k4][ct] = *(const bf16x8*)(Wmain + (size_t)(256 * pn + 128 * (d >> 5) + 32 * wcc + (d & 31)) * 1024 + kk * 32 + 8 * q4); } }
#pragma unroll
            for (int k4 = 0; k4 < 4; ++k4)
#pragma unroll
                for (int ct = 0; ct < 4; ++ct) c4[ct] = __builtin_amdgcn_mfma_f32_16x16x32_bf16(af[k4], bfr[k4][ct], c4[ct], 0, 0, 0);
            LAS f32x4* red = (LAS f32x4*)L;
#pragma unroll
            for (int ct = 0; ct < 4; ++ct) red[(wave * 4 + ct) * 64 + ln] = c4[ct];
            __syncthreads();
            LAS unsigned char* Tm = L + 32768;
            if (wave == 0) {
#pragma unroll
                for (int ct = 0; ct < 4; ++ct) { f32x4 a = red[ct * 64 + ln];
#pragma unroll
                    for (int w = 1; w < 8; ++w) a += red[(w * 4 + ct) * 64 + ln];
                    c4[ct] = a; }
#pragma unroll
                for (int reg = 0; reg < 4; ++reg) {
                    float v[4]; float ss = 0.f;
#pragma unroll
                    for (int ct = 0; ct < 4; ++ct) { v[ct] = c4[ct][reg]; ss += v[ct] * v[ct]; }
                    ss += shfl_xor_local(ss, 1); ss += shfl_xor_local(ss, 2); ss += shfl_xor_local(ss, 4); ss += shfl_xor_local(ss, 8);
                    const float rn = (typ == 0) ? __builtin_amdgcn_rsqf(ss * (1.f / 64.f) + RMS_EPS) : 1.f;
                    const int mi = 4 * q4 + reg;
#pragma unroll
                    for (int ct = 0; ct < 4; ++ct) { const int d = ct * 16 + r16; const float o = (typ == 0) ? v[ct] * rn * gkv[ct] : v[ct];
                        if (typ == 0) Tm[mi * 64 + d] = (unsigned char)(__builtin_amdgcn_cvt_pk_fp8_f32(o, o, 0, false) & 0xff);
                        else ((LAS bf16_t*)Tm)[mi * 64 + d] = (bf16_t)f2bf(o); }
                }
            }
            __syncthreads();
            {
                const int b = threadIdx.x >> 6, w = threadIdx.x & 63, row = w >> 2, piece = w & 3;
                if (typ == 0) {
                    const u32x4 t = *(LAS const u32x4*)(Tm + row * 64 + piece * 16);
                    *(u32x4*)((unsigned char*)Kb + ((size_t)(b * LP + 48 + row)) * 1024 + 128 * hh + piece * 16) = t;
                } else {
                    const u32x4 t0 = *(LAS const u32x4*)(Tm + row * 128 + piece * 32), t1 = *(LAS const u32x4*)(Tm + row * 128 + piece * 32 + 16);
                    unsigned char* dp = (unsigned char*)(typ == 1 ? Vb : Ub) + (((size_t)(b * LP + 48 + row)) * 512 + 64 * hh) * 2 + piece * 32;
                    *(u32x4*)dp = t0; *(u32x4*)(dp + 16) = t1;
                }
            }
            __syncthreads();
        }
#define P1A_RUN() do { pg8::GridOrder S; S.init(HN, Wmain + (size_t)1536 * 1024, MX, 512, 1024, G, bx); EpiInProj E{Qb, Kb, Vb, Ub, Gt, KA->gq, KA->gk, RMS_EPS, 6}; pg8::gemm_phase<EpiInProj, pg8::GridOrder, false>(L, 1024, S, E, wave); } while (0)
#define P1C_RUN() do { pg8::GridOrder S; S.init(HN8, Wg8 + (size_t)2560 * 1024, MX, 1024, 512, G, bx); EpiInProj E{Qb, Kb, Vb, Ub, Gt, KA->gq, KA->gk, RMS_EPS * 1024.0f, 0}; pg8::gemm_phase<EpiInProj, pg8::GridOrder, false, false, false, true>(L, 512, S, E, wave); } while (0)
        const int x8 = bx_f() & 7;
        if (x8 < 4) P1A_RUN();
        if (x8 < 2 || x8 >= 6) P1C_RUN();
        { pg8::GridOrder S; S.init(HN8, Wg8, MX, 2560, 512, G, bx);
          EpiGates8 E{KA->ws};
          pg8::gemm_phase<EpiGates8, pg8::GridOrder, false, false, false, true>(L, 512, S, E, wave); }
        if (x8 >= 2 && x8 < 6) P1C_RUN();
        if (x8 >= 4) P1A_RUN();
#undef P1C_RUN
#undef P1A_RUN
    }
    float lraw[9]; { const KArgsP KA = kargs(); const float* lf0 = LF + (size_t)(vcu >> 2) * LP;
#pragma unroll
      for (int i = 0; i < 9; ++i) { const int p = tid * 9 + i; lraw[i] = (p < LP) ? lf0[p] : 0.f; } }
    float gqa, gka; { const KArgsP KA = kargs(); gqa = fabsf(KA->gq[lane]); gka = fabsf(KA->gk[lane]); }
    GRID_BAR_D(3584, 5376);
    STAMP(2);

    if (PH(2)) {
        const KArgsP KA = kargs();
        if (vcu < 256) attn_body::attn_kv_prefetch((vcu >> 2) >> 3, (vcu >> 2) & 7, (const attn_body::bf16*)Kb, (const attn_body::bf16*)Vb, (char*)lds, wave);
        for (int id = bx * 512 + tid; id < (MX / 16) * 64; id += G * 512) {
            const int rb = id >> 6, ch = id & 63, w = 2 << (ch >> 4), m0 = rb * 16;
            const size_t prow0 = (size_t)m0 + 64 * ((m0 >> 12) + 1);
            const bf16_t* up = Ub + prow0 * 512 + ch * 8;
            float sm[8] = {0.f, 0.f, 0.f, 0.f, 0.f, 0.f, 0.f, 0.f};
#define UNPK(f, v) const float f[8] = {bf_lo(v.x), bf_hi(v.x), bf_lo(v.y), bf_hi(v.y), bf_lo(v.z), bf_hi(v.z), bf_lo(v.w), bf_hi(v.w)}
#pragma unroll
            for (int j = 1; j < 16; ++j) if (j < w) { const u32x4 v = *(const u32x4*)(up - (ptrdiff_t)j * 512); UNPK(f, v);
#pragma unroll
                for (int i = 0; i < 8; ++i) sm[i] += f[i]; }
            const float inv = 1.0f / (float)w;
#pragma unroll
            for (int r = 0; r < 16; ++r) {
                const u32x4 vc = *(const u32x4*)(up + (ptrdiff_t)r * 512), vo = *(const u32x4*)(up + (ptrdiff_t)(r - w + 1) * 512);
                UNPK(fc, vc); UNPK(fo, vo);
                float o8[8];
#pragma unroll
                for (int i = 0; i < 8; ++i) { sm[i] += fc[i]; o8[i] = sm[i] * inv - fc[i]; sm[i] -= fo[i]; }
                u32x4 o; o.x = pk2(o8[0], o8[1]); o.y = pk2(o8[2], o8[3]); o.z = pk2(o8[4], o8[5]); o.w = pk2(o8[6], o8[7]);
                *(u32x4*)((unsigned char*)Ob + (size_t)(m0 + r) * 1536 + 512 + ch * 16) = o;
            }
#undef UNPK
        }
        const int bh = vcu >> 2, u4 = vcu & 3;
        LAS float* kb = (LAS float*)(L + attn_body::LDS_KB);
        LAS float* part = (LAS float*)(L + attn_body::LDS_WS);
        {
            const float* lf = LF + (size_t)bh * LP; float v[9]; float run = 0.f;
#pragma unroll
            for (int i = 0; i < 9; ++i) { v[i] = lraw[i]; run += v[i]; v[i] = run; }
            float inc = run;
#pragma unroll
            for (int o = 1; o < 64; o <<= 1) { const float y = __shfl_up(inc, o); if (lane >= o) inc += y; }
            if (lane == 63) part[wave] = inc;
#pragma unroll
            for (int o = 1; o < 64; o <<= 1) { gqa = fmaxf(gqa, shfl_xor_local(gqa, o)); gka = fmaxf(gka, shfl_xor_local(gka, o)); }
            __syncthreads();
            float base = inc - run;
            for (int w = 0; w < wave; ++w) base += part[w];
#pragma unroll
            for (int i = 0; i < 9; ++i) { const int p = tid * 9 + i; if (p < LP) kb[p] = (p < 48) ? -INFINITY : -(base + v[i]) * LOG2E; }
            __syncthreads();
        }
        if (vcu < 256) {
            const int b = bh >> 3, h = bh & 7;
            const float cbv = C2 * 64.0f * gqa * gka * 1.15f;
            const int qbs[4] = {15 - u4, 11 - u4, 4 + u4, u4};
#pragma unroll 1
            for (int i = 0; i < 4; ++i) attn_body::attn_unit<8>(b, h, qbs[i], (const attn_body::bf16*)Qb, (const attn_body::bf16*)Kb, (const attn_body::bf16*)Vb, (attn_body::bf16*)Ob, (char*)lds, wave, cbv, i == 0);
        }
    }
    GRID_BAR_D(5376, 8960);
    STAMP(3);

    if (PH(3)) {
        const KArgsP KA = kargs();
        pg8::GridOrder S; S.init(Ob, Wa, MX, 1024, 768, G, bx); EpiMerged E{MG, (const unsigned char*)Gt, (const unsigned char*)Gt + (size_t)MX * 1024};
        pg8::gemm_phase<EpiMerged, pg8::GridOrder, false, true, false, false, 4>(L, 768, S, E, wave);
    }
    GRID_BAR_D(8960, 10752);
    STAMP(4);

    if (PH(4)) {
        const KArgsP KA = kargs();
        pg8::GridOrder S; S.init(MG, Wout, MX, 1024, 768, G, bx); EpiResid E{RINV, H1B, SSQ, H1B8};
        if (PROBE_PHASE == 14 && blockIdx.x == 0 && threadIdx.x == 0) ((volatile LAS unsigned long long*)(L + LDSX_OFF + 4096 + 256))[0] = 0;
        pg8::gemm_phase<EpiResid, pg8::GridOrder, false, true, PROBE_PHASE == 14, false, 4>(L, 768, S, E, wave);
    }
    u32x4 wst[12];
    { const KArgsP KA = kargs();
#pragma unroll
      for (int j = 0; j < 12; ++j) { const int i = tid + j * 512, r = i >> 7, c = i & 127; wst[j] = *(const u32x4*)(Wr + (size_t)r * 1024 + c * 8); } }
    GRID_BAR_D(10752, N_DEF_);
    STAMP(5);

    if (PH(5)) {
        const KArgsP KA = kargs();
        constexpr int WRP = 2064;
        LAS unsigned char* WrL = L;
        LAS float* Lg = (LAS float*)(L + 100 * 1024) + wave * (16 * 48);
        LAS int* hist = (LAS int*)(L + LDSX_OFF);
        bf16x8 af[32];
        { const int m0 = bx * 128 + wave * 16, r16 = lane & 15, q4 = lane >> 4; const bf16_t* ap = H1B + (size_t)(m0 + r16) * 1024 + 8 * q4;
#pragma unroll
          for (int kk = 0; kk < 32; ++kk) af[kk] = *(const bf16x8*)(ap + kk * 32); }
#pragma unroll
        for (int j = 0; j < 12; ++j) { const int i = tid + j * 512, r = i >> 7, c = i & 127; *(LAS u32x4*)(WrL + r * WRP + c * 16) = wst[j]; }
        if (tid < 128) hist[tid] = 0;
        LAS float* rbias = (LAS float*)(L + LDSX_OFF + 512);
        if (tid >= 128 && tid < 164) { const int j = tid - 128; rbias[j] = (j < 4) ? KA->b_group[j] : KA->b_router[j - 4]; }
        __syncthreads();
        int my_m = -1, l1 = 0, l2 = 0, r1 = 0, r2 = 0; float w1v = 0.f, w2v = 0.f, rstd = 0.f;
        for (int rb = bx; rb < MX / 128; rb += G) {
            const int m0 = rb * 128 + wave * 16, r16 = lane & 15, q4 = lane >> 4;
            f32x4 c3[3] = {{0.f, 0.f, 0.f, 0.f}, {0.f, 0.f, 0.f, 0.f}, {0.f, 0.f, 0.f, 0.f}};
            f32x4 sq4[4];
#pragma unroll
            for (int p = 0; p < 4; ++p) sq4[p] = *(const f32x4*)(SSQ + (size_t)(m0 + r16) * 16 + 4 * p);
            if (rb != bx) { const bf16_t* ap = H1B + (size_t)(m0 + r16) * 1024 + 8 * q4;
#pragma unroll
              for (int kk = 0; kk < 32; ++kk) af[kk] = *(const bf16x8*)(ap + kk * 32); }
#pragma unroll
            for (int kk = 0; kk < 32; ++kk) {
#pragma unroll
                for (int nt3 = 0; nt3 < 3; ++nt3) { const bf16x8 bb = *(const LAS bf16x8*)(WrL + (nt3 * 16 + r16) * WRP + (kk * 32 + 8 * q4) * 2);
                    c3[nt3] = __builtin_amdgcn_mfma_f32_16x16x32_bf16(af[kk], bb, c3[nt3], 0, 0, 0); }
            }
#pragma unroll
            for (int nt3 = 0; nt3 < 3; ++nt3)
#pragma unroll
                for (int reg = 0; reg < 4; ++reg) Lg[(4 * q4 + reg) * 48 + nt3 * 16 + r16] = c3[nt3][reg];
            asm volatile("s_waitcnt lgkmcnt(0)" ::: "memory");
            if (lane < 16) {
                const int m = m0 + lane; float ss = 0.f;
#pragma unroll
                for (int p = 0; p < 4; ++p) ss += (sq4[p].x + sq4[p].y) + (sq4[p].z + sq4[p].w);
                rstd = 1.0f / sqrtf(ss * (1.f / DM_) + RMS_EPS);
                const LAS float* lg = Lg + lane * 48;
                float gl[4]; int gi = 0; float gm = -INFINITY;
#pragma unroll
                for (int j = 0; j < 4; ++j) { gl[j] = lg[j] * rstd + rbias[j]; if (gl[j] > gm) { gm = gl[j]; gi = j; } }
                float gden = 0.f;
#pragma unroll
                for (int j = 0; j < 4; ++j) gden += expf(gl[j] - gm);
                const float gtop = 1.0f / gden;
                float el[8]; int e1 = 0; float m1 = -INFINITY;
#pragma unroll
                for (int j = 0; j < 8; ++j) { el[j] = lg[4 + gi * 8 + j] * rstd + rbias[4 + gi * 8 + j]; if (el[j] > m1) { m1 = el[j]; e1 = j; } }
                int e2 = 0; float m2 = -INFINITY;
#pragma unroll
                for (int j = 0; j < 8; ++j) if (j != e1 && el[j] > m2) { m2 = el[j]; e2 = j; }
                const float q2 = expf(m2 - m1), inv = gtop / (1.0f + q2);
                w1v = inv; w2v = q2 * inv;
                l1 = gi * 8 + e1; l2 = 32 + gi * 8 + e2; my_m = m;
                r1 = __hip_atomic_fetch_add(hist + l1, 1, __ATOMIC_RELAXED, __HIP_MEMORY_SCOPE_WORKGROUP);
                r2 = __hip_atomic_fetch_add(hist + l2, 1, __ATOMIC_RELAXED, __HIP_MEMORY_SCOPE_WORKGROUP);
            }
            __syncthreads();
            if (tid < 64) { const int n = hist[tid]; hist[64 + tid] = n ? (int)__hip_atomic_fetch_add(ctl + CW_CNT + tid * 64, (unsigned)n, __ATOMIC_RELAXED, __HIP_MEMORY_SCOPE_AGENT) : 0; }
            __syncthreads();
            if (lane < 16 && my_m >= 0) {
                const int p1 = l1 * LCAP + hist[64 + l1] + r1, p2 = l2 * LCAP + hist[64 + l2] + r2;
                TOK[p1] = my_m; RS[p1] = rstd; CWt[p1] = w1v; TOK[p2] = my_m; RS[p2] = rstd; CWt[p2] = w2v;
            }
            if (rb + G < MX / 128) { __syncthreads(); if (tid < 64) hist[tid] = 0; __syncthreads(); }
        }
    }
    GRID_BAR();
    STAMP(6);

    if (PH(6)) {
        const KArgsP KA = kargs();
        LAS int* pre = (LAS int*)(L + LDSX_OFF + 1024);
        LAS int* cntl = (LAS int*)(L + LDSX_OFF + 2048);
        if (wave == 0) {
            const int ln = lane; const int c = (int)__hip_atomic_load(ctl + CW_CNT + ln * 64, __ATOMIC_RELAXED, __HIP_MEMORY_SCOPE_AGENT);
            cntl[ln] = c; const int tl = (c + 255) >> 8; int inc = tl;
#pragma unroll
            for (int o = 1; o < 64; o <<= 1) { const int y = __builtin_amdgcn_ds_bpermute((lane_id() - o) << 2, inc); if (ln >= o) inc += y; }
            pre[ln] = inc - tl; if (ln == 63) pre[64] = inc; }
        __syncthreads();
        if (PH(7)) { MoeOrder<2, true> S{pre, cntl, 0, 64, G, vcu, (const char*)H1B8, (const char*)W13, TOK, 0, 2 * G}; EpiSwiGLU E{KA->ws};
          pg8::gemm_phase<EpiSwiGLU, MoeOrder<2, true>, true, false, false, true>(L, 512, S, E, wave); }
        GRID_BAR();
        STAMP(7);
        if (PH(7)) { MoeOrder<2, true> S{pre, cntl, 0, 64, G, vcu, (const char*)H1B8, (const char*)W13, TOK, 2 * G, -1}; EpiSwiGLU E{KA->ws};
          pg8::gemm_phase<EpiSwiGLU, MoeOrder<2, true>, true, false, false, true>(L, 512, S, E, wave); }
        const int nleft = max(0, 2 * (int)pre[64] - 2 * G), nb = min(nleft, G / 2), v_ = vcu; const bool lo_ = v_ < nb;
        if (PH(8)) { MoeOrder<4, false, 1> S{pre, cntl, 0, 32, lo_ ? G : G - nb, lo_ ? v_ : v_, (const char*)HH, (const char*)W2t, TOK, 0, lo_ ? nb : -1}; EpiScatter<false> E{H1B, KA->out, TOK};
          pg8::gemm_phase<EpiScatter<false>, MoeOrder<4, false, 1>, false, false, false, true>(L, 128, S, E, wave); }
        GRID_BAR();
        STAMP(8);
        if (PH(9)) { MoeOrder<4, false, 1> S{pre, cntl, 32, 32, G, vcu, (const char*)HH, (const char*)W2t, TOK, 0, -1}; EpiScatter<true> E{H1B, KA->out, TOK};
          pg8::gemm_phase<EpiScatter<true>, MoeOrder<4, false, 1>, false, false, false, true>(L, 128, S, E, wave); }
    }
    if (PROBE_PHASE >= 0) { GRID_BAR(); STAMP(9); const KArgsP KA = kargs();
        if (bx == 0 && wave == 0 && lane_id() == 0) { volatile LAS unsigned long long* st = (volatile LAS unsigned long long*)(L + LDSX_OFF + 4096); const float us = (PROBE_PHASE == 14) ? (float)st[32] * 0.01f : (float)(st[PROBE_PHASE + 1] - st[PROBE_PHASE]) * 0.01f; KA->out[0] += us * 0.1f; } }
#undef tid
#undef lane
#undef G
#undef bx
#undef vcu
#undef gw
#undef NGW
}
#undef ctl
#undef Wmain
#undef Wg8
#undef HN8
#undef H1B8
#undef Wa
#undef We
#undef Wout
#undef Wr
#undef HNM
#undef LF
#undef SSQ
#undef RINV
#undef W13
#undef W2t
#undef TOK
#undef RS
#undef CWt
#undef HN
#undef YP
#undef H1B
#undef Gt
#undef HH
#undef Qb
#undef Kb
#undef Vb
#undef Ub
#undef MG
#undef Ob
#undef MIX

extern "C" void kernel_launch(void* const* d_in, const int* in_sizes, int n_in, void* d_out, int out_size, void* d_ws, size_t ws_size, hipStream_t stream) {
    static int grid = 0;
    if (grid == 0) {
        if (n_in != 20 || in_sizes[0] != MX * DM_ || out_size != MX * DM_ || ws_size < WS_END) { fprintf(stderr, "kernel_launch: unexpected shapes (n_in %d, in0 %d, out %d, ws %zu)\n", n_in, n_in > 0 ? in_sizes[0] : -1, out_size, ws_size); grid = -1; return; }
        int dev = 0, cus = 0, per_cu = 0;
        if (hipGetDevice(&dev) != hipSuccess || hipDeviceGetAttribute(&cus, hipDeviceAttributeMultiprocessorCount, dev) != hipSuccess) { grid = -1; return; }
        if (hipFuncSetAttribute((const void*)fwd_megakernel, hipFuncAttributeMaxDynamicSharedMemorySize, LDS_BYTES) != hipSuccess) { fprintf(stderr, "kernel_launch: hipFuncSetAttribute failed\n"); grid = -1; return; }
        if (hipOccupancyMaxActiveBlocksPerMultiprocessor(&per_cu, (const void*)fwd_megakernel, 512, LDS_BYTES) != hipSuccess || per_cu < 1) { fprintf(stderr, "kernel_launch: occupancy query says %d\n", per_cu); (void)hipGetLastError(); grid = -1; return; }
        grid = cus;
        if (grid != 256) fprintf(stderr, "kernel_launch: %d CUs (built for 256)\n", grid);
    }
    if (grid < 0) return;
    (void)hipMemsetAsync((char*)d_ws + WS_CTL, 0, CTL_BYTES, stream);
    Args a{};
    a.x = (const float*)d_in[0]; a.meta = (const float*)d_in[1]; a.g_mix = (const float*)d_in[2]; a.w_in = (const float*)d_in[3]; a.b_forget = (const float*)d_in[4];
    a.gq = (const float*)d_in[5]; a.gk = (const float*)d_in[6]; a.w_up_attn = (const float*)d_in[7]; a.w_pool = (const float*)d_in[8]; a.pool_scale = (const float*)d_in[9];
    a.w_up_pool = (const float*)d_in[10]; a.w_out = (const float*)d_in[11]; a.g_ffn = (const float*)d_in[12]; a.w_group = (const float*)d_in[13]; a.b_group = (const float*)d_in[14];
    a.w_router = (const float*)d_in[15]; a.b_router = (const float*)d_in[16]; a.w1 = (const float*)d_in[17]; a.w3 = (const float*)d_in[18]; a.w2 = (const float*)d_in[19];
    a.out = (float*)d_out; a.ws = (unsigned char*)d_ws;
    void* kargs[] = {&a};
    hipError_t e = hipLaunchCooperativeKernel((void*)fwd_megakernel, dim3(grid), dim3(512), kargs, LDS_BYTES, stream);
    if (e != hipSuccess) fprintf(stderr, "cooperative launch failed: %s (grid %d)\n", hipGetErrorString(e), grid);
}
```
